# Optimizing an MI355X kernel written in HIP

```python
import jax, jax.numpy as jnp
from jax import lax
import numpy as np

D_MODEL = 1024
BATCH = 4
SEQ = 4096
DEPTH = 1

CHUNK = 64
SB_HEADS = 8
SB_HEAD_DIM = 64
SB_WIDTH = SB_HEADS * SB_HEAD_DIM
Q_BLOCK = 128
S5_WIDTH = D_MODEL // 2
S5_GROUP = 16
S5_GROUPS = S5_WIDTH // S5_GROUP
S5_STATE = 64
S5_DT_MIN = 1e-3
S5_DT_MAX = 1e-1
N_EXPERTS = 32
TOP_K = 4
D_FF = D_MODEL
SWIGLU_LIMIT = 7.0
SWIGLU_ALPHA = 1.702
RMS_EPS = 1e-5
OFF_K = SB_WIDTH
OFF_V = 2 * SB_WIDTH
OFF_U = 3 * SB_WIDTH
OFF_GA = OFF_U + S5_WIDTH
OFF_GB = OFF_GA + D_MODEL
IN_WIDTH = OFF_GB + D_MODEL

kernel_name = "hybrid_stickbreak_s5_moe_block"


def rmsnorm(x, g):
    xf = x.astype(jnp.float32)
    return xf * lax.rsqrt(jnp.mean(xf * xf, axis=-1, keepdims=True) + RMS_EPS) * g.astype(jnp.float32)


def split_heads(t):
    b, l, _ = t.shape
    return t.reshape(b, l, SB_HEADS, SB_HEAD_DIM).transpose(0, 2, 1, 3)


def stick_breaking_attention(q, k, v):
    scale = SB_HEAD_DIM ** -0.5
    seq = q.shape[2]
    outs = []
    for start in range(0, seq, Q_BLOCK):
        end = start + Q_BLOCK
        qb = q[:, :, start:end]
        kb = k[:, :, :end]
        vb = v[:, :, :end]
        z = jnp.einsum('bhqd,bhkd->bhqk', qb, kb).astype(jnp.float32) * scale
        before = jnp.arange(end)[None, :] < jnp.arange(start, end)[:, None]
        log_keep = jnp.where(before, jax.nn.log_sigmoid(-z), 0.0)
        later = lax.cumsum(log_keep, axis=3, reverse=True) - log_keep
        w = jnp.where(before, jnp.exp(jax.nn.log_sigmoid(z) + later), 0.0)
        outs.append(jnp.einsum('bhqk,bhkd->bhqd', w, vb.astype(jnp.float32)))
    return jnp.concatenate(outs, axis=2)


def s5_mixer(u, lam_re, lam_im, b_re, b_im, c_re, c_im, d_skip, log_step, w_glu):
    f32 = jnp.float32
    bsz, seq, _ = u.shape
    uf = u.astype(f32).reshape(bsz, seq, S5_GROUPS, S5_GROUP)
    lam = lax.complex(lam_re.astype(f32), lam_im.astype(f32))
    step = jnp.exp(log_step.astype(f32))[:, None]
    lam_bar = jnp.exp(lam * step)
    b_mat = lax.complex(b_re.astype(f32), b_im.astype(f32))
    b_bar = ((lam_bar - 1.0) / lam)[:, :, None] * b_mat
    bu = jnp.einsum('gph,blgh->blgp', b_bar, uf)
    decay = jnp.broadcast_to(lam_bar, (1, seq, S5_GROUPS, S5_STATE))

    def combine(left, right):
        a_l, s_l = left
        a_r, s_r = right
        return a_l * a_r, a_r * s_l + s_r

    _, states = lax.associative_scan(combine, (decay, bu), axis=1)
    c_mat = lax.complex(c_re.astype(f32), c_im.astype(f32))
    y = jnp.real(jnp.einsum('ghp,blgp->blgh', c_mat, states)) + d_skip.astype(f32) * uf
    y = jax.nn.gelu(y.reshape(bsz, seq, S5_WIDTH))
    return y * jax.nn.sigmoid(y @ w_glu)


def moe_ffn(h, w_router, b_router, w_up, b_up, w_down, b_down):
    bsz, seq, d = h.shape
    t = h.reshape(bsz * seq, d)
    logits = (t @ w_router + b_router).astype(jnp.float32)
    top_val, top_idx = lax.top_k(logits, TOP_K)
    top_w = jax.nn.softmax(top_val, axis=-1)
    gates = jnp.sum(jax.nn.one_hot(top_idx, N_EXPERTS, dtype=jnp.float32) * top_w[..., None], axis=1)
    out = jnp.zeros((bsz * seq, d), jnp.float32)
    for e in range(N_EXPERTS):
        hid = t @ w_up[e] + b_up[e]
        glu = jnp.minimum(hid[:, :D_FF], SWIGLU_LIMIT)
        lin = jnp.clip(hid[:, D_FF:], -SWIGLU_LIMIT, SWIGLU_LIMIT)
        act = glu * jax.nn.sigmoid(SWIGLU_ALPHA * glu) * (lin + 1.0)
        out = out + gates[:, e:e + 1] * (act @ w_down[e] + b_down[e])
    return out.reshape(bsz, seq, d)


def setup_inputs(seed: int = 0) -> dict:
    key = jax.random.key(seed)
    ks = jax.random.split(key, 24)
    f32 = jnp.float32

    def nrm(k, shape, scale):
        return jax.random.normal(k, shape, f32) * scale

    L = DEPTH
    G, P, H = S5_GROUPS, S5_STATE, S5_GROUP
    n_idx = jnp.arange(P, dtype=f32)
    return {
        "x": nrm(ks[0], (BATCH, SEQ, D_MODEL), 1.0),
        "norm_mix": 1.0 + nrm(ks[1], (L, D_MODEL), 0.02),
        "w_in": nrm(ks[2], (L, D_MODEL, IN_WIDTH), D_MODEL ** -0.5),
        "s5_lam_re": -0.5 + nrm(ks[3], (L, G, P), 0.01),
        "s5_lam_im": jnp.pi * n_idx + nrm(ks[4], (L, G, P), 0.01),
        "s5_b_re": nrm(ks[5], (L, G, P, H), (2 * H) ** -0.5),
        "s5_b_im": nrm(ks[6], (L, G, P, H), (2 * H) ** -0.5),
        "s5_c_re": nrm(ks[7], (L, G, H, P), (2 * P) ** -0.5),
        "s5_c_im": nrm(ks[8], (L, G, H, P), (2 * P) ** -0.5),
        "s5_d": nrm(ks[9], (L, G, H), 1.0),
        "s5_log_step": jax.random.uniform(ks[10], (L, G), f32, float(np.log(S5_DT_MIN)), float(np.log(S5_DT_MAX))),
        "w_glu": nrm(ks[11], (L, S5_WIDTH, S5_WIDTH), S5_WIDTH ** -0.5),
        "w_branch_sb": nrm(ks[12], (L, SB_WIDTH, D_MODEL), SB_WIDTH ** -0.5),
        "w_branch_s5": nrm(ks[13], (L, S5_WIDTH, D_MODEL), S5_WIDTH ** -0.5),
        "w_out": nrm(ks[14], (L, D_MODEL, D_MODEL), D_MODEL ** -0.5),
        "norm_ffn": 1.0 + nrm(ks[15], (L, D_MODEL), 0.02),
        "w_router": nrm(ks[16], (L, D_MODEL, N_EXPERTS), D_MODEL ** -0.5),
        "b_router": nrm(ks[17], (L, N_EXPERTS), 0.01),
        "w_up": nrm(ks[18], (L, N_EXPERTS, D_MODEL, 2 * D_FF), D_MODEL ** -0.5),
        "b_up": nrm(ks[19], (L, N_EXPERTS, 2 * D_FF), 0.01),
        "w_down": nrm(ks[20], (L, N_EXPERTS, D_FF, D_MODEL), D_FF ** -0.5),
        "b_down": nrm(ks[21], (L, N_EXPERTS, D_MODEL), 0.01),
        "norm_final": 1.0 + nrm(ks[22], (D_MODEL,), 0.02),
    }


def reference(x, norm_mix, w_in, s5_lam_re, s5_lam_im, s5_b_re, s5_b_im, s5_c_re, s5_c_im,
              s5_d, s5_log_step, w_glu, w_branch_sb, w_branch_s5, w_out, norm_ffn,
              w_router, b_router, w_up, b_up, w_down, b_down, norm_final):
    bsz, seq, _ = x.shape
    for l in range(DEPTH):
        h = rmsnorm(x, norm_mix[l])
        proj = h @ w_in[l]
        q = split_heads(proj[..., :OFF_K])
        k = split_heads(proj[..., OFF_K:OFF_V])
        v = split_heads(proj[..., OFF_V:OFF_U])
        u = proj[..., OFF_U:OFF_GA]
        gate_sb = jax.nn.sigmoid(proj[..., OFF_GA:OFF_GB])
        gate_s5 = jax.nn.sigmoid(proj[..., OFF_GB:])
        y_sb = stick_breaking_attention(q, k, v).transpose(0, 2, 1, 3).reshape(bsz, seq, SB_WIDTH)
        y_s5 = s5_mixer(u, s5_lam_re[l], s5_lam_im[l], s5_b_re[l], s5_b_im[l], s5_c_re[l], s5_c_im[l],
                        s5_d[l], s5_log_step[l], w_glu[l])
        merged = gate_sb * (y_sb @ w_branch_sb[l]) + gate_s5 * (y_s5 @ w_branch_s5[l])
        x = x + (merged @ w_out[l]).astype(x.dtype)
        h = rmsnorm(x, norm_ffn[l])
        x = x + moe_ffn(h, w_router[l], b_router[l], w_up[l], b_up[l], w_down[l], b_down[l]).astype(x.dtype)
    return rmsnorm(x, norm_final).astype(x.dtype)
```

```cpp
#include <hip/hip_runtime.h>
#include <cstdio>
#include <cstdint>

typedef unsigned short bf16_t;
#define LAS __attribute__((address_space(3)))
#define GAS __attribute__((address_space(1)))
typedef short bf16x8 __attribute__((ext_vector_type(8)));
typedef float f32x4 __attribute__((ext_vector_type(4)));
typedef float f32x2 __attribute__((ext_vector_type(2)));
typedef float f32x16 __attribute__((ext_vector_type(16)));
typedef unsigned u32x4 __attribute__((ext_vector_type(4)));
typedef unsigned u32x2 __attribute__((ext_vector_type(2)));

#ifndef MOE_FP8
#define MOE_FP8 1
#endif
constexpr int NB = 4, SEQ = 4096, D = 1024, T = NB * SEQ;
constexpr int NH = 8, HD = 64, SBW = 512, S5W = 512, S5G = 32, S5H = 16, S5P = 64;
constexpr int NE = 32, TOPK = 4, DFF = 1024, INW = 4096;
constexpr int OFF_K = 512, OFF_V = 1024, OFF_U = 1536, OFF_GA = 2048, OFF_GB = 3072;
constexpr float RMS_EPS = 1e-5f, LIMIT = 7.0f, ALPHA = 1.702f;
constexpr float LOG2E = 1.4426950408889634f, LN2 = 0.6931471805599453f;
constexpr float C2 = 0.125f * LOG2E;
constexpr int LC = 16, NCHUNK = T / LC;
constexpr int ACT_ROWS = T * TOPK + NE * 256;

constexpr size_t MiB = 1u << 20;
constexpr size_t WS_CTL = 0, CTL_BYTES = 64 * 1024;
constexpr size_t WS_RSTD1 = 1 * MiB, WS_RSTD2 = 1 * MiB + 65536, WS_RB = 1 * MiB + 131072;
constexpr size_t WS_RS2L = 799 * MiB  , WS_END2 = 801 * MiB;
constexpr size_t WS_X1BF = 802 * MiB  , WS_END3 = 834 * MiB;
constexpr size_t WS_LIST = 2 * MiB, WS_GATEL = 4 * MiB, WS_SS2P = 6 * MiB  , WS_WR = 7 * MiB  ;
constexpr size_t WS_XB = 8 * MiB, WS_QB = 40 * MiB, WS_KB = 56 * MiB, WS_VT = 72 * MiB, WS_UB = 88 * MiB;
constexpr size_t WS_GSB = 104 * MiB, WS_GS5 = 136 * MiB, WS_YSB = 168 * MiB, WS_Y2 = 184 * MiB, WS_YS5 = 200 * MiB;
constexpr size_t WS_MRG = 216 * MiB, WS_X1B = 248 * MiB, WS_ACT = 280 * MiB, WS_YSLOT = 424 * MiB;
constexpr size_t WS_WIN = 552 * MiB  , WS_WGLU = 560 * MiB, WS_WBSB = 561 * MiB, WS_WBS5 = 562 * MiB, WS_WOUT = 563 * MiB;
constexpr size_t WS_M1T = 565 * MiB  , WS_YT = 569 * MiB  ;
constexpr size_t WS_SLOC = 575 * MiB  , WS_SIN = 591 * MiB  ;
constexpr size_t WS_WUP = 607 * MiB  , WS_WDN = 735 * MiB  , WS_END = 799 * MiB;
constexpr size_t WS_TMPA = 280 * MiB;
constexpr size_t WS_TMPM = 8 * MiB;
constexpr int CW_TMO = 0, CW_QATT = 256  , CW_QCVT = 320  , CW_YDONE = 384  , CW_CNT = 1024  , CW_BAR = 4096  ;

__device__ __forceinline__ float bf2f(bf16_t v) { return __uint_as_float(((unsigned)v) << 16); }
__device__ __forceinline__ bf16_t f2bf(float f) { unsigned u = __float_as_uint(f); u += 0x7fffu + ((u >> 16) & 1u); return (bf16_t)(u >> 16); }
__device__ __forceinline__ float ldf(const float* p) { return *p; }
__device__ __forceinline__ float ldf(const bf16_t* p) { return bf2f(*p); }
__device__ __forceinline__ float bflo(unsigned w) { return __uint_as_float(w << 16); }
__device__ __forceinline__ float bfhi(unsigned w) { return __uint_as_float(w & 0xffff0000u); }
typedef __bf16 bf16x2_t __attribute__((ext_vector_type(2)));
__device__ __forceinline__ unsigned cvt_pk_bf16(float lo, float hi) { const f32x2 v = {lo, hi}; const bf16x2_t b = __builtin_convertvector(v, bf16x2_t); return __builtin_bit_cast(unsigned, b); }
__device__ __forceinline__ float sigmoidf_(float x) { return 1.0f / (1.0f + expf(-x)); }
__device__ __forceinline__ float fast_sigmoid(float x) { return __builtin_amdgcn_rcpf(1.0f + __builtin_amdgcn_exp2f(-LOG2E * x)); }
__device__ __forceinline__ float wave_sum(float v) {
#pragma unroll
    for (int o = 1; o < 64; o <<= 1) v += __shfl_xor(v, o);
    return v;
}
__device__ __forceinline__ float gelu_tanh(float x) {
    const float u = 0.7978845608028654f * (x + 0.044715f * x * x * x);
    return x * __builtin_amdgcn_rcpf(1.0f + __builtin_amdgcn_exp2f(-2.0f * LOG2E * u));
}
namespace pg {
constexpr int BM = 256, BK = 64, HALF = 128, HTB = HALF * BK * 2  , STAGE_BYTES = 8 * HTB;
__device__ __forceinline__ int lds_byte(int r, int c) { const int st = (r >> 4) * 2 + (c >> 5), rr = r & 15, cc = c & 31, ob = rr * 64 + cc * 2; return st * 1024 + (ob ^ (((ob >> 9) & 1) << 5)); }
__device__ __forceinline__ void stage_rc(int b, int& R, int& C) { const int st = b / 1024, sb = b % 1024, swz = sb ^ (((sb >> 9) & 1) << 5); R = (st >> 1) * 16 + swz / 64; C = (st & 1) * 32 + (swz % 64) / 2; }
__device__ __forceinline__ int perm32(int rho) { const int n = rho >> 4, i = rho & 15; return 8 * (i >> 2) + 4 * n + (i & 3); }

struct GUnit { const char* A; const char* A2; const char* B; const int* list; const float* bias; int pm, pn, x0, x1, nvalid, bstep; };

template <class Src, class Epi, class Sched>
__device__ __forceinline__ void gemm_phase(LAS unsigned char* lds, const Src& G, const Sched& S, const Epi& E) {
    const int tid = threadIdx.x, wid = __builtin_amdgcn_readfirstlane(tid >> 6), lane = tid & 63, wr = wid >> 2, wc = wid & 3, fr = lane & 15, fq = lane >> 4;
    const int nt = G.nt();
    int sR[2], sC[2];
#pragma unroll
    for (int i = 0; i < 2; ++i) stage_rc(tid * 16 + i * 8192, sR[i], sC[i]);
    unsigned voffB[2];
#pragma unroll
    for (int i = 0; i < 2; ++i) { const int Rb = Epi::PERM ? ((sR[i] & ~31) + perm32(sR[i] & 31)) : sR[i]; voffB[i] = G.b_off(Rb, sC[i]); }
    const size_t bh = G.b_hstep();
    const unsigned ldsw = (unsigned)wid * 1024u;
    const int aoff = lds_byte(wr * 64 + fr, fq * 8), boff = lds_byte(wc * 32 + fr, fq * 8);
#define PG_SA(b, h) (((b) * 2 + (h)) * HTB)
#define PG_SB(b, h) ((4 + (b) * 2 + (h)) * HTB)
#define PG_STAGE2(bufoff, gbase, o0, o1) do { \
        __builtin_amdgcn_global_load_lds((const unsigned*)((const char*)(gbase) + (o0)), (LAS unsigned*)(lds + (bufoff) + ldsw), 16, 0, 0); \
        __builtin_amdgcn_global_load_lds((const unsigned*)((const char*)(gbase) + (o1)), (LAS unsigned*)(lds + (bufoff) + ldsw + 8192), 16, 0, 0); } while (0)
#define PG_STAGE(bufoff, gbase, voff) PG_STAGE2(bufoff, gbase, (voff)[0], (voff)[1])
#define PG_LDA(dst, b, h) do { _Pragma("unroll") for (int m = 0; m < 4; ++m) _Pragma("unroll") for (int k = 0; k < 2; ++k) dst[m][k] = *(const LAS bf16x8*)(lds + PG_SA(b, h) + aoff + m * 2048 + k * 1024); } while (0)
#define PG_LDB(dst, b, h) do { _Pragma("unroll") for (int n = 0; n < 2; ++n) _Pragma("unroll") for (int k = 0; k < 2; ++k) dst[n][k] = *(const LAS bf16x8*)(lds + PG_SB(b, h) + boff + n * 2048 + k * 1024); } while (0)
#define PG_MMA(ai, bj, At, Bt) do { __builtin_amdgcn_s_setprio(1); _Pragma("unroll") for (int m = 0; m < 4; ++m) _Pragma("unroll") for (int n = 0; n < 2; ++n) _Pragma("unroll") for (int k = 0; k < 2; ++k) \
        acc[ai][bj][m][n] = __builtin_amdgcn_mfma_f32_16x16x32_bf16(Bt[n][k], At[m][k], acc[ai][bj][m][n], 0, 0, 0); __builtin_amdgcn_s_setprio(0); } while (0)
#define PG_WAIT_V(n) asm volatile("s_waitcnt vmcnt(" #n ")" ::: "memory")
#define PG_WAIT_L(n) asm volatile("s_waitcnt lgkmcnt(" #n ")" ::: "memory")
#define PG_BAR __builtin_amdgcn_s_barrier()
#define PG_SCHED __builtin_amdgcn_sched_barrier(0)
    GUnit cur, nxt; int ui = 0;
    if (!S.next(0, cur)) return;
    unsigned vA00 = G.a_off(cur, sR[0], sC[0]), vA01 = G.a_off(cur, sR[1], sC[1]), vA10 = G.a_off(cur, sR[0] + HALF, sC[0]), vA11 = G.a_off(cur, sR[1] + HALF, sC[1]);
    unsigned vN00 = vA00, vN01 = vA01, vN10 = vA10, vN11 = vA11;
    f32x4 acc[2][2][4][2];
#pragma unroll
    for (int a = 0; a < 2; ++a)
#pragma unroll
        for (int b = 0; b < 2; ++b)
#pragma unroll
            for (int m = 0; m < 4; ++m)
#pragma unroll
                for (int n = 0; n < 2; ++n) acc[a][b][m][n] = (f32x4){0.f, 0.f, 0.f, 0.f};
    bf16x8 At[4][2], B0[2][2], B1[2][2];
    { const char* a0 = G.a_tile(cur, 0); const char* b0 = G.b_tile(cur, 0); const char* a1 = G.a_tile(cur, 1); const char* b1 = G.b_tile(cur, 1);
      PG_STAGE(PG_SB(0, 0), b0, voffB); PG_STAGE(PG_SB(0, 1), b0 + bh, voffB); PG_STAGE2(PG_SA(0, 0), a0, vA00, vA01); PG_STAGE2(PG_SA(0, 1), a0, vA10, vA11);
      if (wr == 1) PG_BAR;
      PG_WAIT_V(2); PG_BAR;
      PG_STAGE(PG_SB(1, 0), b1, voffB); PG_STAGE2(PG_SA(1, 0), a1, vA00, vA01); PG_STAGE(PG_SB(1, 1), b1 + bh, voffB);
      PG_WAIT_V(6); PG_BAR; }
    for (;;) {
        const bool has_next = S.next(ui + 1, nxt);
        if constexpr (Src::A_PER_UNIT) {
            if (has_next) { vN00 = G.a_off(nxt, sR[0], sC[0]); vN01 = G.a_off(nxt, sR[1], sC[1]); vN10 = G.a_off(nxt, sR[0] + HALF, sC[0]); vN11 = G.a_off(nxt, sR[1] + HALF, sC[1]); }
        }
        const char* nA0 = has_next ? G.a_tile(nxt, 0) : G.a_tile(cur, 0); const char* nA1 = has_next ? G.a_tile(nxt, 1) : G.a_tile(cur, 1);
        const char* nB0 = has_next ? G.b_tile(nxt, 0) : G.b_tile(cur, 0); const char* nB1 = has_next ? G.b_tile(nxt, 1) : G.b_tile(cur, 1);
        for (int t = 0; t < nt; t += 2) {
            const bool last = (t == nt - 2);
            const char* a1 = G.a_tile(cur, t + 1);
            const char* a2 = last ? nA0 : G.a_tile(cur, t + 2); const char* b2 = last ? nB0 : G.b_tile(cur, t + 2);
            const char* a3 = last ? nA1 : G.a_tile(cur, t + 3); const char* b3 = last ? nB1 : G.b_tile(cur, t + 3);
            PG_LDB(B0, 0, 0); PG_LDB(B1, 0, 1); PG_SCHED; PG_LDA(At, 0, 0); PG_STAGE2(PG_SA(1, 1), a1, vA10, vA11);
            if constexpr (Src::A_PER_UNIT) { vA00 = last ? vN00 : vA00; vA01 = last ? vN01 : vA01; vA10 = last ? vN10 : vA10; vA11 = last ? vN11 : vA11; }
            PG_WAIT_V(8); PG_WAIT_L(0); PG_BAR; PG_MMA(0, 0, At, B0); PG_MMA(0, 1, At, B1); PG_BAR; PG_SCHED;
            PG_LDA(At, 0, 1); PG_STAGE(PG_SB(0, 0), b2, voffB); PG_STAGE(PG_SB(0, 1), b2 + bh, voffB); PG_STAGE2(PG_SA(0, 0), a2, vA00, vA01);
            PG_WAIT_V(8); PG_WAIT_L(0); PG_BAR; PG_MMA(1, 0, At, B0); PG_MMA(1, 1, At, B1); PG_BAR; PG_SCHED;
            PG_LDB(B0, 1, 0); PG_LDB(B1, 1, 1); PG_SCHED; PG_LDA(At, 1, 0); PG_STAGE2(PG_SA(0, 1), a2, vA10, vA11);
            PG_WAIT_V(8); PG_WAIT_L(0); PG_BAR; PG_MMA(0, 0, At, B0); PG_MMA(0, 1, At, B1); PG_BAR; PG_SCHED;
            PG_LDA(At, 1, 1); PG_STAGE(PG_SB(1, 0), b3, voffB); PG_STAGE(PG_SB(1, 1), b3 + bh, voffB); PG_STAGE2(PG_SA(1, 0), a3, vA00, vA01);
            PG_WAIT_V(8); PG_WAIT_L(0); PG_BAR; PG_MMA(1, 0, At, B0); PG_MMA(1, 1, At, B1); PG_BAR; PG_SCHED;
        }
        if (wr == 0) PG_BAR;
        E(acc, cur, wr, wc, fr, fq);
        if (!has_next) break;
#pragma unroll
        for (int a = 0; a < 2; ++a)
#pragma unroll
            for (int b = 0; b < 2; ++b)
#pragma unroll
                for (int m = 0; m < 4; ++m)
#pragma unroll
                    for (int n = 0; n < 2; ++n) acc[a][b][m][n] = (f32x4){0.f, 0.f, 0.f, 0.f};
        cur = nxt; ++ui;
        if (wr == 1) PG_BAR;
    }
    PG_WAIT_V(0);
    PG_BAR;
#undef PG_SA
#undef PG_SB
#undef PG_STAGE
#undef PG_STAGE2
#undef PG_LDA
#undef PG_LDB
#undef PG_MMA
#undef PG_WAIT_V
#undef PG_WAIT_L
#undef PG_BAR
#undef PG_SCHED
}

typedef int i32x8 __attribute__((ext_vector_type(8)));
template <class Src, class Epi, class Sched>
__device__ __forceinline__ void gemm_phase_f8(LAS unsigned char* lds, const Src& G, const Sched& S, const Epi& E) {
    const int tid = threadIdx.x, wid = __builtin_amdgcn_readfirstlane(tid >> 6), lane = tid & 63, wr = wid >> 2, wc = wid & 3, fr = lane & 15, fq = lane >> 4;
    const int nt = G.nt();
    int sR[2], sC[2];
#pragma unroll
    for (int i = 0; i < 2; ++i) stage_rc(tid * 16 + i * 8192, sR[i], sC[i]);
    unsigned voffB[2];
#pragma unroll
    for (int i = 0; i < 2; ++i) { const int Rb = Epi::PERM ? ((sR[i] & ~31) + perm32(sR[i] & 31)) : sR[i]; voffB[i] = G.b_off(Rb, sC[i]); }
    const size_t bh = G.b_hstep();
    const unsigned ldsw = (unsigned)wid * 1024u;
    const int aoff0 = lds_byte(wr * 64 + fr, fq * 16), boff0 = lds_byte(wc * 32 + fr, fq * 16);
    const int aoffF = aoff0 + ((fq & 1) << 4), aoffS = aoff0 + (((fq & 1) ^ 1) << 4), boffF = boff0 + ((fq & 1) << 4), boffS = boff0 + (((fq & 1) ^ 1) << 4);
    const int scl = G.scale_ab();
#define PG_SA(b, h) (((b) * 2 + (h)) * HTB)
#define PG_SB(b, h) ((4 + (b) * 2 + (h)) * HTB)
#define PG_STAGE2(bufoff, gbase, o0, o1) do { \
        __builtin_amdgcn_global_load_lds((const unsigned*)((const char*)(gbase) + (o0)), (LAS unsigned*)(lds + (bufoff) + ldsw), 16, 0, 0); \
        __builtin_amdgcn_global_load_lds((const unsigned*)((const char*)(gbase) + (o1)), (LAS unsigned*)(lds + (bufoff) + ldsw + 8192), 16, 0, 0); } while (0)
#define PG_STAGE(bufoff, gbase, voff) PG_STAGE2(bufoff, gbase, (voff)[0], (voff)[1])
#define PG_LDA(dst, b, h) do { _Pragma("unroll") for (int m = 0; m < 4; ++m) { const u32x4 _l = *(const LAS u32x4*)(lds + PG_SA(b, h) + aoffF + m * 2048), _h = *(const LAS u32x4*)(lds + PG_SA(b, h) + aoffS + m * 2048); \
        dst[m] = (i32x8){(int)_l.x, (int)_l.y, (int)_l.z, (int)_l.w, (int)_h.x, (int)_h.y, (int)_h.z, (int)_h.w}; } } while (0)
#define PG_LDB(dst, b, h) do { _Pragma("unroll") for (int n = 0; n < 2; ++n) { const u32x4 _l = *(const LAS u32x4*)(lds + PG_SB(b, h) + boffF + n * 2048), _h = *(const LAS u32x4*)(lds + PG_SB(b, h) + boffS + n * 2048); \
        dst[n] = (i32x8){(int)_l.x, (int)_l.y, (int)_l.z, (int)_l.w, (int)_h.x, (int)_h.y, (int)_h.z, (int)_h.w}; } } while (0)
#define PG_MMA(ai, bj, At, Bt) do { __builtin_amdgcn_s_setprio(1); _Pragma("unroll") for (int m = 0; m < 4; ++m) _Pragma("unroll") for (int n = 0; n < 2; ++n) \
        asm volatile("v_mfma_scale_f32_16x16x128_f8f6f4 %0, %1, %2, %0, %3, %3 op_sel_hi:[0,0,0]" : "+v"(acc[ai][bj][m][n]) : "v"(Bt[n]), "v"(At[m]), "v"(scl)); __builtin_amdgcn_s_setprio(0); } while (0)
#define PG_WAIT_V(n) asm volatile("s_waitcnt vmcnt(" #n ")" ::: "memory")
#define PG_WAIT_L(n) asm volatile("s_waitcnt lgkmcnt(" #n ")" ::: "memory")
#define PG_BAR __builtin_amdgcn_s_barrier()
#define PG_SCHED __builtin_amdgcn_sched_barrier(0)
    GUnit cur, nxt; int ui = 0;
    if (!S.next(0, cur)) return;
    unsigned vA00 = G.a_off(cur, sR[0], sC[0]), vA01 = G.a_off(cur, sR[1], sC[1]), vA10 = G.a_off(cur, sR[0] + HALF, sC[0]), vA11 = G.a_off(cur, sR[1] + HALF, sC[1]);
    unsigned vN00 = vA00, vN01 = vA01, vN10 = vA10, vN11 = vA11;
    f32x4 acc[2][2][4][2];
#pragma unroll
    for (int a = 0; a < 2; ++a)
#pragma unroll
        for (int b = 0; b < 2; ++b)
#pragma unroll
            for (int m = 0; m < 4; ++m)
#pragma unroll
                for (int n = 0; n < 2; ++n) acc[a][b][m][n] = (f32x4){0.f, 0.f, 0.f, 0.f};
    i32x8 At[4], B0[2], B1[2];
    { const char* a0 = G.a_tile(cur, 0); const char* b0 = G.b_tile(cur, 0); const char* a1 = G.a_tile(cur, 1); const char* b1 = G.b_tile(cur, 1);
      PG_STAGE(PG_SB(0, 0), b0, voffB); PG_STAGE(PG_SB(0, 1), b0 + bh, voffB); PG_STAGE2(PG_SA(0, 0), a0, vA00, vA01); PG_STAGE2(PG_SA(0, 1), a0, vA10, vA11);
      if (wr == 1) PG_BAR;
      PG_WAIT_V(2); PG_BAR;
      PG_STAGE(PG_SB(1, 0), b1, voffB); PG_STAGE2(PG_SA(1, 0), a1, vA00, vA01); PG_STAGE(PG_SB(1, 1), b1 + bh, voffB);
      PG_WAIT_V(6); PG_BAR; }
    for (;;) {
        const bool has_next = S.next(ui + 1, nxt);
        if constexpr (Src::A_PER_UNIT) {
            if (has_next) { vN00 = G.a_off(nxt, sR[0], sC[0]); vN01 = G.a_off(nxt, sR[1], sC[1]); vN10 = G.a_off(nxt, sR[0] + HALF, sC[0]); vN11 = G.a_off(nxt, sR[1] + HALF, sC[1]); }
        }
        const char* nA0 = has_next ? G.a_tile(nxt, 0) : G.a_tile(cur, 0); const char* nA1 = has_next ? G.a_tile(nxt, 1) : G.a_tile(cur, 1);
        const char* nB0 = has_next ? G.b_tile(nxt, 0) : G.b_tile(cur, 0); const char* nB1 = has_next ? G.b_tile(nxt, 1) : G.b_tile(cur, 1);
        for (int t = 0; t < nt; t += 2) {
            const bool last = (t == nt - 2);
            const char* a1 = G.a_tile(cur, t + 1);
            const char* a2 = last ? nA0 : G.a_tile(cur, t + 2); const char* b2 = last ? nB0 : G.b_tile(cur, t + 2);
            const char* a3 = last ? nA1 : G.a_tile(cur, t + 3); const char* b3 = last ? nB1 : G.b_tile(cur, t + 3);
            PG_LDB(B0, 0, 0); PG_LDB(B1, 0, 1); PG_SCHED; PG_LDA(At, 0, 0); PG_STAGE2(PG_SA(1, 1), a1, vA10, vA11);
            if constexpr (Src::A_PER_UNIT) { vA00 = last ? vN00 : vA00; vA01 = last ? vN01 : vA01; vA10 = last ? vN10 : vA10; vA11 = last ? vN11 : vA11; }
            PG_WAIT_V(8); PG_WAIT_L(0); PG_BAR; PG_MMA(0, 0, At, B0); PG_MMA(0, 1, At, B1); PG_BAR; PG_SCHED;
            PG_LDA(At, 0, 1); PG_STAGE(PG_SB(0, 0), b2, voffB); PG_STAGE(PG_SB(0, 1), b2 + bh, voffB); PG_STAGE2(PG_SA(0, 0), a2, vA00, vA01);
            PG_WAIT_V(8); PG_WAIT_L(0); PG_BAR; PG_MMA(1, 0, At, B0); PG_MMA(1, 1, At, B1); PG_BAR; PG_SCHED;
            PG_LDB(B0, 1, 0); PG_LDB(B1, 1, 1); PG_SCHED; PG_LDA(At, 1, 0); PG_STAGE2(PG_SA(0, 1), a2, vA10, vA11);
            PG_WAIT_V(8); PG_WAIT_L(0); PG_BAR; PG_MMA(0, 0, At, B0); PG_MMA(0, 1, At, B1); PG_BAR; PG_SCHED;
            PG_LDA(At, 1, 1); PG_STAGE(PG_SB(1, 0), b3, voffB); PG_STAGE(PG_SB(1, 1), b3 + bh, voffB); PG_STAGE2(PG_SA(1, 0), a3, vA00, vA01);
            PG_WAIT_V(8); PG_WAIT_L(0); PG_BAR; PG_MMA(1, 0, At, B0); PG_MMA(1, 1, At, B1); PG_BAR; PG_SCHED;
        }
        asm volatile("s_nop 15\n\ts_nop 15" ::: "memory");
        if (wr == 0) PG_BAR;
        E(acc, cur, wr, wc, fr, fq);
        if (!has_next) break;
#pragma unroll
        for (int a = 0; a < 2; ++a)
#pragma unroll
            for (int b = 0; b < 2; ++b)
#pragma unroll
                for (int m = 0; m < 4; ++m)
#pragma unroll
                    for (int n = 0; n < 2; ++n) acc[a][b][m][n] = (f32x4){0.f, 0.f, 0.f, 0.f};
        cur = nxt; ++ui;
        if (wr == 1) PG_BAR;
    }
    PG_WAIT_V(0);
    PG_BAR;
#undef PG_SA
#undef PG_SB
#undef PG_STAGE
#undef PG_STAGE2
#undef PG_LDA
#undef PG_LDB
#undef PG_MMA
#undef PG_WAIT_V
#undef PG_WAIT_L
#undef PG_BAR
#undef PG_SCHED
}

template <class Src, class Epi, class Sched>
__device__ __forceinline__ void gemm_phase_f8m(LAS unsigned char* lds, LAS unsigned char* meta, const Src& G, const Sched& S, const Epi& E) {
    const int tid = threadIdx.x, wid = __builtin_amdgcn_readfirstlane(tid >> 6), lane = tid & 63, wr = wid >> 2, wc = wid & 3, fr = lane & 15, fq = lane >> 4;
    const int nt = G.nt();
    int sR[2], sC[2];
#pragma unroll
    for (int i = 0; i < 2; ++i) stage_rc(tid * 16 + i * 8192, sR[i], sC[i]);
    unsigned voffB[2];
#pragma unroll
    for (int i = 0; i < 2; ++i) { const int Rb = Epi::PERM ? ((sR[i] & ~31) + perm32(sR[i] & 31)) : sR[i]; voffB[i] = G.b_off(Rb, sC[i]); }
    const size_t bh = G.b_hstep();
    const unsigned ldsw = (unsigned)wid * 1024u;
    const int aoff0 = lds_byte(wr * 64 + fr, fq * 16), boff0 = lds_byte(wc * 32 + fr, fq * 16);
    const int aoffF = aoff0 + ((fq & 1) << 4), aoffS = aoff0 + (((fq & 1) ^ 1) << 4), boffF = boff0 + ((fq & 1) << 4), boffS = boff0 + (((fq & 1) ^ 1) << 4);
    const int scl = G.scale_ab();
#define PG_SA(b, h) (((b) * 2 + (h)) * HTB)
#define PG_SB(b, h) ((4 + (b) * 2 + (h)) * HTB)
#define PG_STAGE2(bufoff, gbase, o0, o1) do { \
        __builtin_amdgcn_global_load_lds((const unsigned*)((const char*)(gbase) + (o0)), (LAS unsigned*)(lds + (bufoff) + ldsw), 16, 0, 0); \
        __builtin_amdgcn_global_load_lds((const unsigned*)((const char*)(gbase) + (o1)), (LAS unsigned*)(lds + (bufoff) + ldsw + 8192), 16, 0, 0); } while (0)
#define PG_STAGE(bufoff, gbase, voff) PG_STAGE2(bufoff, gbase, (voff)[0], (voff)[1])
#define PG_LDA(dst, b, h) do { _Pragma("unroll") for (int m = 0; m < 4; ++m) { const u32x4 _l = *(const LAS u32x4*)(lds + PG_SA(b, h) + aoffF + m * 2048), _h = *(const LAS u32x4*)(lds + PG_SA(b, h) + aoffS + m * 2048); \
        dst[m] = (i32x8){(int)_l.x, (int)_l.y, (int)_l.z, (int)_l.w, (int)_h.x, (int)_h.y, (int)_h.z, (int)_h.w}; } } while (0)
#define PG_LDB(dst, b, h) do { _Pragma("unroll") for (int n = 0; n < 2; ++n) { const u32x4 _l = *(const LAS u32x4*)(lds + PG_SB(b, h) + boffF + n * 2048), _h = *(const LAS u32x4*)(lds + PG_SB(b, h) + boffS + n * 2048); \
        dst[n] = (i32x8){(int)_l.x, (int)_l.y, (int)_l.z, (int)_l.w, (int)_h.x, (int)_h.y, (int)_h.z, (int)_h.w}; } } while (0)
#define PG_MMA(ai, bj, At, Bt) do { __builtin_amdgcn_s_setprio(1); _Pragma("unroll") for (int m = 0; m < 4; ++m) _Pragma("unroll") for (int n = 0; n < 2; ++n) \
        asm volatile("v_mfma_scale_f32_16x16x128_f8f6f4 %0, %1, %2, %0, %3, %3 op_sel_hi:[0,0,0]" : "+v"(acc[ai][bj][m][n]) : "v"(Bt[n]), "v"(At[m]), "v"(scl)); __builtin_amdgcn_s_setprio(0); } while (0)
#define PG_WAIT_V(n) asm volatile("s_waitcnt vmcnt(" #n ")" ::: "memory")
#define PG_WAIT_L(n) asm volatile("s_waitcnt lgkmcnt(" #n ")" ::: "memory")
#define PG_BAR __builtin_amdgcn_s_barrier()
#define PG_SCHED __builtin_amdgcn_sched_barrier(0)
#define PG_META(u, slot) do { const int _e = (tid & 255) < (u).nvalid ? (tid & 255) : (u).nvalid - 1; const unsigned* _p = tid < 256 ? (const unsigned*)((u).list + _e) : (const unsigned*)((const float*)(u).A2 + _e); \
        __builtin_amdgcn_global_load_lds(_p, (LAS unsigned*)(meta + (slot) * 3072 + (wid >> 2) * 1024 + (wid & 3) * 256), 4, 0, 0); \
        if (tid < 256) { const unsigned* _b = (const unsigned*)((u).bias + ((tid & 128) ? (u).bstep - 128 : 0) + tid); \
            __builtin_amdgcn_global_load_lds(_b, (LAS unsigned*)(meta + (slot) * 3072 + 2048 + (wid & 3) * 256), 4, 0, 0); } } while (0)
    GUnit cur, nxt; int ui = 0, sl = 0;
    if (!S.next(0, cur)) return;
    PG_META(cur, 0); PG_WAIT_V(0); PG_BAR;
    unsigned vA00 = G.a_offm(meta, sR[0], sC[0]), vA01 = G.a_offm(meta, sR[1], sC[1]), vA10 = G.a_offm(meta, sR[0] + HALF, sC[0]), vA11 = G.a_offm(meta, sR[1] + HALF, sC[1]);
    unsigned vN00 = vA00, vN01 = vA01, vN10 = vA10, vN11 = vA11;
    f32x4 acc[2][2][4][2];
#pragma unroll
    for (int a = 0; a < 2; ++a)
#pragma unroll
        for (int b = 0; b < 2; ++b)
#pragma unroll
            for (int m = 0; m < 4; ++m)
#pragma unroll
                for (int n = 0; n < 2; ++n) acc[a][b][m][n] = (f32x4){0.f, 0.f, 0.f, 0.f};
    i32x8 At[4], B0[2], B1[2];
    { const char* a0 = G.a_tile(cur, 0); const char* b0 = G.b_tile(cur, 0); const char* a1 = G.a_tile(cur, 1); const char* b1 = G.b_tile(cur, 1);
      PG_STAGE(PG_SB(0, 0), b0, voffB); PG_STAGE(PG_SB(0, 1), b0 + bh, voffB); PG_STAGE2(PG_SA(0, 0), a0, vA00, vA01); PG_STAGE2(PG_SA(0, 1), a0, vA10, vA11);
      if (wr == 1) PG_BAR;
      PG_WAIT_V(2); PG_BAR;
      PG_STAGE(PG_SB(1, 0), b1, voffB); PG_STAGE2(PG_SA(1, 0), a1, vA00, vA01); PG_STAGE(PG_SB(1, 1), b1 + bh, voffB);
      PG_WAIT_V(6); PG_BAR; }
    for (;;) {
        const bool has_next = S.next(ui + 1, nxt);
        const int sn = sl == 2 ? 0 : sl + 1;
        if (has_next) PG_META(nxt, sn);
        const char* nA0 = has_next ? G.a_tile(nxt, 0) : G.a_tile(cur, 0); const char* nA1 = has_next ? G.a_tile(nxt, 1) : G.a_tile(cur, 1);
        const char* nB0 = has_next ? G.b_tile(nxt, 0) : G.b_tile(cur, 0); const char* nB1 = has_next ? G.b_tile(nxt, 1) : G.b_tile(cur, 1);
        for (int t = 0; t < nt; t += 2) {
            const bool last = (t == nt - 2);
            const char* a1 = G.a_tile(cur, t + 1);
            const char* a2 = last ? nA0 : G.a_tile(cur, t + 2); const char* b2 = last ? nB0 : G.b_tile(cur, t + 2);
            const char* a3 = last ? nA1 : G.a_tile(cur, t + 3); const char* b3 = last ? nB1 : G.b_tile(cur, t + 3);
            PG_LDB(B0, 0, 0); PG_LDB(B1, 0, 1); PG_SCHED; PG_LDA(At, 0, 0); PG_STAGE2(PG_SA(1, 1), a1, vA10, vA11);
            if constexpr (Src::A_PER_UNIT) { if (last && has_next) { LAS unsigned char* mn = meta + sn * 3072;
                vA00 = G.a_offm(mn, sR[0], sC[0]); vA01 = G.a_offm(mn, sR[1], sC[1]); vA10 = G.a_offm(mn, sR[0] + HALF, sC[0]); vA11 = G.a_offm(mn, sR[1] + HALF, sC[1]); } }
            PG_WAIT_V(8); PG_WAIT_L(0); PG_BAR; PG_MMA(0, 0, At, B0); PG_MMA(0, 1, At, B1); PG_BAR; PG_SCHED;
            PG_LDA(At, 0, 1); PG_STAGE(PG_SB(0, 0), b2, voffB); PG_STAGE(PG_SB(0, 1), b2 + bh, voffB); PG_STAGE2(PG_SA(0, 0), a2, vA00, vA01);
            PG_WAIT_V(8); PG_WAIT_L(0); PG_BAR; PG_MMA(1, 0, At, B0); PG_MMA(1, 1, At, B1); PG_BAR; PG_SCHED;
            PG_LDB(B0, 1, 0); PG_LDB(B1, 1, 1); PG_SCHED; PG_LDA(At, 1, 0); PG_STAGE2(PG_SA(0, 1), a2, vA10, vA11);
            PG_WAIT_V(8); PG_WAIT_L(0); PG_BAR; PG_MMA(0, 0, At, B0); PG_MMA(0, 1, At, B1); PG_BAR; PG_SCHED;
            PG_LDA(At, 1, 1); PG_STAGE(PG_SB(1, 0), b3, voffB); PG_STAGE(PG_SB(1, 1), b3 + bh, voffB); PG_STAGE2(PG_SA(1, 0), a3, vA00, vA01);
            PG_WAIT_V(8); PG_WAIT_L(0); PG_BAR; PG_MMA(1, 0, At, B0); PG_MMA(1, 1, At, B1); PG_BAR; PG_SCHED;
        }
        asm volatile("s_nop 15\n\ts_nop 15" ::: "memory");
        if (wr == 0) PG_BAR;
        E(acc, cur, wr, wc, fr, fq, meta + sl * 3072);
        if (!has_next) break;
#pragma unroll
        for (int a = 0; a < 2; ++a)
#pragma unroll
            for (int b = 0; b < 2; ++b)
#pragma unroll
                for (int m = 0; m < 4; ++m)
#pragma unroll
                    for (int n = 0; n < 2; ++n) acc[a][b][m][n] = (f32x4){0.f, 0.f, 0.f, 0.f};
        cur = nxt; ++ui; sl = sn;
        if (wr == 1) PG_BAR;
    }
    PG_WAIT_V(0);
    PG_BAR;
#undef PG_META
#undef PG_SA
#undef PG_SB
#undef PG_STAGE
#undef PG_STAGE2
#undef PG_LDA
#undef PG_LDB
#undef PG_MMA
#undef PG_WAIT_V
#undef PG_WAIT_L
#undef PG_BAR
#undef PG_SCHED
}

struct SrcPlain {
    static constexpr bool A_PER_UNIT = false;
    int K;
    __device__ __forceinline__ int nt() const { return K / BK; }
    __device__ __forceinline__ const char* a_tile(const GUnit& u, int t) const { return u.A + (size_t)t * (BK * 2); }
    __device__ __forceinline__ const char* b_tile(const GUnit& u, int t) const { return u.B + (size_t)t * (BK * 2); }
    __device__ __forceinline__ unsigned a_off(const GUnit&, int R, int C) const { return (unsigned)(R * K + C) * 2u; }
    __device__ __forceinline__ unsigned b_off(int R, int C) const { return (unsigned)(R * K + C) * 2u; }
    __device__ __forceinline__ size_t b_hstep() const { return (size_t)HALF * K * 2; }
};
struct SrcGather {
    static constexpr bool A_PER_UNIT = true;
    int K;
    __device__ __forceinline__ int nt() const { return K / BK; }
    __device__ __forceinline__ const char* a_tile(const GUnit& u, int t) const { return u.A + (size_t)t * (BK * 2); }
    __device__ __forceinline__ const char* b_tile(const GUnit& u, int t) const { return u.B + (size_t)t * (BK * 2); }
    __device__ __forceinline__ unsigned a_off(const GUnit& u, int R, int C) const { const int rr = R < u.nvalid ? R : u.nvalid - 1; const int tok = u.list[rr] >> 2; return (unsigned)(tok * K + C) * 2u; }
    __device__ __forceinline__ unsigned b_off(int R, int C) const { return (unsigned)(R * K + C) * 2u; }
    __device__ __forceinline__ size_t b_hstep() const { return (size_t)HALF * K * 2; }
};
struct SrcPlain8 {
    static constexpr bool A_PER_UNIT = false;
    __device__ __forceinline__ unsigned a_offm(LAS unsigned char*, int R, int C) const { return (unsigned)(R * Kb + 2 * C); }
    int Kb, wexp;
    __device__ __forceinline__ int nt() const { return Kb / 128; }
    __device__ __forceinline__ int scale_ab() const { const int e = 127 - wexp / 2; return e | (e << 8) | (e << 16) | (e << 24); }
    __device__ __forceinline__ const char* a_tile(const GUnit& u, int t) const { return u.A + (size_t)t * 128; }
    __device__ __forceinline__ const char* b_tile(const GUnit& u, int t) const { return u.B + (size_t)t * 128; }
    __device__ __forceinline__ unsigned a_off(const GUnit&, int R, int C) const { return (unsigned)(R * Kb + 2 * C); }
    __device__ __forceinline__ unsigned b_off(int R, int C) const { return (unsigned)(R * Kb + 2 * C); }
    __device__ __forceinline__ size_t b_hstep() const { return (size_t)HALF * Kb; }
};
struct SrcGather8 {
    static constexpr bool A_PER_UNIT = true;
    __device__ __forceinline__ unsigned a_offm(LAS unsigned char* mslot, int R, int C) const { const int tok = ((LAS int*)mslot)[R] >> 2; return (unsigned)(tok * Kb + 2 * C); }
    int Kb, wexp;
    __device__ __forceinline__ int nt() const { return Kb / 128; }
    __device__ __forceinline__ int scale_ab() const { const int e = 127 - wexp / 2; return e | (e << 8) | (e << 16) | (e << 24); }
    __device__ __forceinline__ const char* a_tile(const GUnit& u, int t) const { return u.A + (size_t)t * 128; }
    __device__ __forceinline__ const char* b_tile(const GUnit& u, int t) const { return u.B + (size_t)t * 128; }
    __device__ __forceinline__ unsigned a_off(const GUnit& u, int R, int C) const { const int rr = R < u.nvalid ? R : u.nvalid - 1; const int tok = u.list[rr] >> 2; return (unsigned)(tok * Kb + 2 * C); }
    __device__ __forceinline__ unsigned b_off(int R, int C) const { return (unsigned)(R * Kb + 2 * C); }
    __device__ __forceinline__ size_t b_hstep() const { return (size_t)HALF * Kb; }
};
}
#define XB_TMO      128
#define XB_XCNT(j)  (256  + 64 * (j))
#define XB_XSUB(j)  (1280 + 64 * (j))
#define XB_XGEN(j)  (2304 + 64 * (j))
#define XB_TOP      3328
#define XB_TOPGEN   3392
#define XCD_BAR_WORDS 3456
#define XB_SPIN_CAP (1u << 18)

__device__ __forceinline__ unsigned xb_ld(unsigned* p)              { return __hip_atomic_load(p, __ATOMIC_RELAXED, __HIP_MEMORY_SCOPE_AGENT); }
__device__ __forceinline__ unsigned xb_add(unsigned* p, unsigned v) { return __hip_atomic_fetch_add(p, v, __ATOMIC_RELAXED, __HIP_MEMORY_SCOPE_AGENT); }
__device__ __forceinline__ unsigned xb_xcc_id() { return (unsigned)__builtin_amdgcn_s_getreg((3 << 11) | 20) & 0xFu; }
#define XB_SPIN(cond, bar) do { unsigned _sp = 0; while (cond) { __builtin_amdgcn_s_sleep(1); \
    if ((++_sp & 255u) == 0u) { if (xb_ld(&(bar)[XB_TMO])) break; if (_sp > XB_SPIN_CAP) { atomicAdd(&(bar)[XB_TMO], 1u); break; } } } } while (0)

struct XcdBarrier {
    unsigned* bar; unsigned x;
    volatile LAS unsigned* st;
};

__device__ __forceinline__ XcdBarrier xcd_barrier_post(unsigned* bar, volatile LAS unsigned* st) {
    XcdBarrier b; b.bar = bar; b.x = xb_xcc_id(); b.st = st;
    if (threadIdx.x == 0) (void)xb_add(&bar[XB_XCNT(b.x)], 1u);
    return b;
}
__device__ __forceinline__ void xcd_barrier_complete(unsigned* bar, unsigned x, unsigned& nloc, unsigned& nx) {
    const unsigned G = gridDim.x * gridDim.y * gridDim.z;
    unsigned sum, cnt, mine, sp = 0u;
    for (;;) {
        sum = 0u; cnt = 0u; mine = 0u;
#pragma unroll
        for (unsigned j = 0; j < 16; ++j) { const unsigned c = xb_ld(&bar[XB_XCNT(j)]); sum += c; cnt += (c > 0u) ? 1u : 0u; mine = (j == x) ? c : mine; }
        if (sum == G) break;
        __builtin_amdgcn_s_sleep(1);
        if ((++sp & 255u) == 0u) { if (xb_ld(&bar[XB_TMO])) break; if (sp > XB_SPIN_CAP) { atomicAdd(&bar[XB_TMO], 1u); break; } }
    }
    nloc = mine > 0u ? mine : 1u; nx = cnt > 0u ? cnt : 1u;
}

__device__ __forceinline__ void xcd_barrier(const XcdBarrier& b) {
    asm volatile("s_waitcnt vmcnt(0)" ::: "memory");
    __syncthreads();
    if (threadIdx.x == 0) {
        unsigned* bar = b.bar;
        __builtin_amdgcn_s_waitcnt(0);
        unsigned nloc = b.st[0], nx = b.st[1];
        if (nloc == 0u) { xcd_barrier_complete(bar, b.x, nloc, nx); b.st[0] = nloc; b.st[1] = nx; }
        const unsigned old = xb_add(&bar[XB_XSUB(b.x)], 1u);
        const unsigned gen = old / nloc;
        if (old + 1u == (gen + 1u) * nloc) {
            __builtin_amdgcn_fence(__ATOMIC_RELEASE, "agent");
            asm volatile("s_waitcnt vmcnt(0)" ::: "memory");
            const unsigned og = xb_add(&bar[XB_TOP], 1u);
            const unsigned tg = og / nx;
            if (og + 1u == (tg + 1u) * nx) xb_add(&bar[XB_TOPGEN], 1u);
            else XB_SPIN(xb_ld(&bar[XB_TOPGEN]) == tg, bar);
            __builtin_amdgcn_fence(__ATOMIC_ACQUIRE, "agent");
            xb_add(&bar[XB_XGEN(b.x)], 1u);
            asm volatile("s_waitcnt vmcnt(0)" ::: "memory");
        } else {
            XB_SPIN(xb_ld(&bar[XB_XGEN(b.x)]) == gen, bar);
            __builtin_amdgcn_fence(__ATOMIC_ACQUIRE, "agent");
            asm volatile("s_waitcnt vmcnt(0)" ::: "memory");
        }
    }
    __syncthreads();
}
constexpr int NWAVES = 8;
constexpr int RING_BYTES = 131072, MISC_OFF = RING_BYTES + 320, META_OFF = RING_BYTES + 1024  , LDS_BYTES = 147456;
struct Frame {
    LAS unsigned char* lds; volatile LAS unsigned* MISC;
    unsigned* ctl;
    int tid, lane, wave, G, bid;
    const float *x, *norm_mix, *w_in, *lam_re, *lam_im, *b_re, *b_im, *c_re, *c_im, *s5d, *log_step, *w_glu, *w_bsb, *w_bs5, *w_out, *norm_ffn, *w_router, *b_router, *w_up, *b_up, *w_down, *b_down, *norm_final;
    float* out; unsigned char* ws;
    float *RSTD1, *RSTD2, *GATEL, *SS2P, *SLOC; int *RB, *LIST;
    bf16_t *X1BF, *XB, *QB, *KB, *VT, *UB, *GSB, *GS5, *YSB, *Y2, *YS5, *MRG, *X1B, *ACT, *YSLOT, *WIN, *WGLU, *WBSB, *WBS5, *WOUT, *WR, *M1T, *YT, *SIN, *WUP, *WDN;
};

__device__ __forceinline__ void p0_tr_item(const float* __restrict__ W, int ldw, int K, const float* __restrict__ kscale, bf16_t* __restrict__ WT, int k0, int n0, int drow0, LAS unsigned* scr, int lane) {
    const int q = lane >> 4, a = lane & 15;
    f32x4 v0[8], v1[8];
#pragma unroll
    for (int i = 0; i < 8; ++i) { const int kk = k0 + 8 * i + 2 * q;
        v0[i] = *(const f32x4*)(W + (size_t)kk * ldw + n0 + 4 * a); v1[i] = *(const f32x4*)(W + (size_t)(kk + 1) * ldw + n0 + 4 * a); }
#pragma unroll
    for (int i = 0; i < 8; ++i) { const int kl = 8 * i + 2 * q; float s0 = 1.f, s1 = 1.f; if (kscale) { s0 = kscale[k0 + kl]; s1 = kscale[k0 + kl + 1]; }
#pragma unroll
        for (int j = 0; j < 4; ++j) scr[(4 * a + j) * 33 + (kl >> 1)] = cvt_pk_bf16(v0[i][j] * s0, v1[i][j] * s1); }
    asm volatile("s_waitcnt lgkmcnt(0)" ::: "memory");
    const int c = lane & 7;
#pragma unroll
    for (int i2 = 0; i2 < 8; ++i2) { const int row = (lane >> 3) + 8 * i2; u32x4 o;
        o.x = scr[row * 33 + 4 * c]; o.y = scr[row * 33 + 4 * c + 1]; o.z = scr[row * 33 + 4 * c + 2]; o.w = scr[row * 33 + 4 * c + 3];
        *(u32x4*)(WT + (size_t)(drow0 + row) * K + k0 + 8 * c) = o; }
    asm volatile("s_waitcnt lgkmcnt(0)" ::: "memory");
}
__device__ __forceinline__ unsigned pk4_fp8(float a, float b, float c, float d) {
    a = __builtin_fminf(__builtin_fmaxf(a, -448.f), 448.f); b = __builtin_fminf(__builtin_fmaxf(b, -448.f), 448.f); c = __builtin_fminf(__builtin_fmaxf(c, -448.f), 448.f); d = __builtin_fminf(__builtin_fmaxf(d, -448.f), 448.f);
    int w = __builtin_amdgcn_cvt_pk_fp8_f32(a, b, 0, false); w = __builtin_amdgcn_cvt_pk_fp8_f32(c, d, w, true); return (unsigned)w;
}
__device__ __forceinline__ void p0_tr_item8(const float* __restrict__ W, int ldw, int K, const float* __restrict__ kscale, float wmul, unsigned char* __restrict__ WT, int k0, int n0, int drow0, LAS unsigned* scr, int lane) {
    const int q = lane >> 4, a = lane & 15;
    f32x4 v[4][4];
#pragma unroll
    for (int i = 0; i < 4; ++i)
#pragma unroll
        for (int r = 0; r < 4; ++r) v[i][r] = *(const f32x4*)(W + (size_t)(k0 + 16 * i + 4 * q + r) * ldw + n0 + 4 * a);
#pragma unroll
    for (int i = 0; i < 4; ++i) { float s[4];
#pragma unroll
        for (int r = 0; r < 4; ++r) s[r] = kscale ? kscale[k0 + 16 * i + 4 * q + r] * wmul : wmul;
#pragma unroll
        for (int j = 0; j < 4; ++j) scr[(4 * a + j) * 17 + 4 * i + q] = pk4_fp8(v[i][0][j] * s[0], v[i][1][j] * s[1], v[i][2][j] * s[2], v[i][3][j] * s[3]); }
    asm volatile("s_waitcnt lgkmcnt(0)" ::: "memory");
    const int c = lane & 3;
#pragma unroll
    for (int i2 = 0; i2 < 4; ++i2) { const int row = (lane >> 2) + 16 * i2; u32x4 o;
        o.x = scr[row * 17 + 4 * c]; o.y = scr[row * 17 + 4 * c + 1]; o.z = scr[row * 17 + 4 * c + 2]; o.w = scr[row * 17 + 4 * c + 3];
        *(u32x4*)(WT + (size_t)(drow0 + row) * K + k0 + 16 * c) = o; }
    asm volatile("s_waitcnt lgkmcnt(0)" ::: "memory");
}
__device__ __forceinline__ void cpow_lam(float lr, float li, float step, float& br, float& bi) { const float mag = expf(lr * step); float sn, cs; sincosf(li * step, &sn, &cs); br = mag * cs; bi = mag * sn; }

__device__ __forceinline__ void p0_s5_tables(Frame& F, int g) {
    LAS float* pwr = (LAS float*)F.lds;
    LAS float* pwi = pwr + 17 * 64;
    LAS float* bbr = pwi + 17 * 64;
    LAS float* bbi = bbr + 1024;
    LAS float* Cr = bbi + 1024;
    LAS float* Ci = Cr + 1024;
    LAS float* Kt = Ci + 1024;
    const int tid = F.tid; const float step = expf(F.log_step[g]);
    if (tid < 64) { const int p = tid; float br, bi; cpow_lam(F.lam_re[g * S5P + p], F.lam_im[g * S5P + p], step, br, bi); float r = 1.f, im = 0.f;
        for (int n = 0; n <= 16; ++n) { pwr[n * 64 + p] = r; pwi[n * 64 + p] = im; const float nr = r * br - im * bi, ni = r * bi + im * br; r = nr; im = ni; } }
#pragma unroll
    for (int rep = 0; rep < 2; ++rep) { const int idx = tid + 512 * rep, p = idx >> 4, h = idx & 15;
        const float lr = F.lam_re[g * S5P + p], li = F.lam_im[g * S5P + p]; float br, bi; cpow_lam(lr, li, step, br, bi);
        const float nr = br - 1.0f, ni = bi, den = lr * lr + li * li, fr = (nr * lr + ni * li) / den, fi = (ni * lr - nr * li) / den;
        const float b0 = F.b_re[(g * S5P + p) * S5H + h], b1 = F.b_im[(g * S5P + p) * S5H + h];
        bbr[p * 16 + h] = fr * b0 - fi * b1; bbi[p * 16 + h] = fr * b1 + fi * b0;
        Cr[idx] = F.c_re[g * 1024 + idx]; Ci[idx] = F.c_im[g * 1024 + idx]; }
    __syncthreads();
#pragma unroll 1
    for (int rep = 0; rep < 8; ++rep) { const int idx = tid + 512 * rep, tau = idx >> 8, h = (idx >> 4) & 15, h2 = idx & 15; float s = 0.f;
        for (int p = 0; p < 64; ++p) { const float cr = Cr[h * 64 + p], ci = Ci[h * 64 + p], pr = pwr[tau * 64 + p], pi = pwi[tau * 64 + p];
            const float xr = cr * pr - ci * pi, xi = cr * pi + ci * pr; s += xr * bbr[p * 16 + h2] - xi * bbi[p * 16 + h2]; }
        if (tau == 0 && h == h2) s += F.s5d[g * S5H + h];
        Kt[idx] = s; }
    __syncthreads();
    unsigned* YT32 = (unsigned*)(F.YT + (size_t)g * 256 * 384);
#pragma unroll 1
    for (int idx = tid; idx < 256 * 192; idx += 512) { const int row = idx / 192, cp = idx % 192, i = row >> 4, h = row & 15; float v[2];
#pragma unroll
        for (int e = 0; e < 2; ++e) { const int col = 2 * cp + e;
            if (col < 256) { const int j = col >> 4, h2 = col & 15; v[e] = (j <= i) ? Kt[(i - j) * 256 + h * 16 + h2] : 0.f; }
            else { const int n = col - 256, p = n & 63; const float cr = Cr[h * 64 + p], ci = Ci[h * 64 + p], pr = pwr[(i + 1) * 64 + p], pi = pwi[(i + 1) * 64 + p];
                v[e] = (n < 64) ? (cr * pr - ci * pi) : -(cr * pi + ci * pr); } }
        YT32[idx] = cvt_pk_bf16(v[0], v[1]); }
    unsigned* M32 = (unsigned*)(F.M1T + (size_t)g * 256 * 256);
#pragma unroll 1
    for (int idx = tid; idx < 256 * 128; idx += 512) { const int row = idx >> 7, cp = idx & 127; float v[2] = {0.f, 0.f};
        if (row < 128) { const int p = row & 63;
#pragma unroll
            for (int e = 0; e < 2; ++e) { const int k = 2 * cp + e, j = k >> 4, h2 = k & 15; const float pr = pwr[(15 - j) * 64 + p], pi = pwi[(15 - j) * 64 + p], br = bbr[p * 16 + h2], bi = bbi[p * 16 + h2];
                v[e] = (row < 64) ? (pr * br - pi * bi) : (pr * bi + pi * br); } }
        M32[idx] = cvt_pk_bf16(v[0], v[1]); }
    __syncthreads();
}

__device__ __forceinline__ void p0_prologue(Frame& F) {
    if (F.bid < S5G) p0_s5_tables(F, F.bid);
    const int gw = F.bid * NWAVES + F.wave, NGW = F.G * NWAVES, lane = F.lane;
    for (int m = gw; m < T; m += 2 * NGW) {
        const int m2 = m + NGW; const bool two = m2 < T;
        const f32x4* xr = (const f32x4*)(F.x + (size_t)m * D) + lane; const f32x4* xr2 = (const f32x4*)(F.x + (size_t)(two ? m2 : m) * D) + lane; f32x4 v[4], w[4]; float s = 0.f, s2 = 0.f;
#pragma unroll
        for (int j = 0; j < 4; ++j) { v[j] = __builtin_nontemporal_load(xr + 64 * j); w[j] = __builtin_nontemporal_load(xr2 + 64 * j); }
#pragma unroll
        for (int j = 0; j < 4; ++j) { s += (v[j].x * v[j].x + v[j].y * v[j].y) + (v[j].z * v[j].z + v[j].w * v[j].w); s2 += (w[j].x * w[j].x + w[j].y * w[j].y) + (w[j].z * w[j].z + w[j].w * w[j].w); }
        s = wave_sum(s); s2 = wave_sum(s2);
        if (lane == 0) { F.RSTD1[m] = rsqrtf(s * (1.0f / D) + RMS_EPS); if (two) F.RSTD1[m2] = rsqrtf(s2 * (1.0f / D) + RMS_EPS); }
        u32x2* o = (u32x2*)(F.XB + (size_t)m * D) + lane; u32x2* o2 = (u32x2*)(F.XB + (size_t)m2 * D) + lane;
#pragma unroll
        for (int j = 0; j < 4; ++j) { u32x2 q; q.x = cvt_pk_bf16(v[j].x, v[j].y); q.y = cvt_pk_bf16(v[j].z, v[j].w); o[64 * j] = q; if (two) { u32x2 q2; q2.x = cvt_pk_bf16(w[j].x, w[j].y); q2.y = cvt_pk_bf16(w[j].z, w[j].w); o2[64 * j] = q2; } }
    }
    for (int idx = gw * 64 + lane; idx < NE * D; idx += NGW * 64) { const int e = idx >> 10, k = idx & 1023; const float w = F.norm_ffn[k] * F.w_router[k * NE + e];
        const bf16_t hi = f2bf(w); F.WR[idx] = hi; F.WR[NE * D + idx] = f2bf(w - bf2f(hi)); }
    LAS unsigned* scr = (LAS unsigned*)(F.lds + 49152 + F.wave * 8448);
    constexpr int I_IN = 16 * 64, I_GLU = 8 * 8, I_BR = 8 * 16, I_OUT = 16 * 16;
    constexpr int NITEMS = I_IN + I_GLU + 2 * I_BR + I_OUT;
    for (int it = gw; it < NITEMS; it += NGW) {
        int r = it;
        if (r < I_IN) { const int kb = r >> 6, nb = r & 63, n0 = nb * 64;
            const int drow = n0 < OFF_V ? n0 : (n0 < OFF_U ? 3584 + (n0 - OFF_V) : n0 - 512);
            p0_tr_item(F.w_in, INW, D, F.norm_mix, F.WIN, kb * 64, n0, drow, scr, lane); continue; } r -= I_IN;
        if (r < I_GLU) { p0_tr_item(F.w_glu, S5W, S5W, nullptr, F.WGLU, (r >> 3) * 64, (r & 7) * 64, (r & 7) * 64, scr, lane); continue; } r -= I_GLU;
        if (r < I_BR) { p0_tr_item(F.w_bsb, D, SBW, nullptr, F.WBSB, (r >> 4) * 64, (r & 15) * 64, (r & 15) * 64, scr, lane); continue; } r -= I_BR;
        if (r < I_BR) { p0_tr_item(F.w_bs5, D, S5W, nullptr, F.WBS5, (r >> 4) * 64, (r & 15) * 64, (r & 15) * 64, scr, lane); continue; } r -= I_BR;
        p0_tr_item(F.w_out, D, D, nullptr, F.WOUT, (r >> 4) * 64, (r & 15) * 64, (r & 15) * 64, scr, lane);
    }
}
constexpr int I_UP = NE * 16 * 32, I_DN = NE * 16 * 16;
struct CvtItem { const float* W; const float* ks; unsigned char* WT; int ldw, K, k0, n0, drow0; float kf; };
__device__ __forceinline__ CvtItem cvt_decode(const Frame& F, int r) {
    CvtItem c;
    if (r < I_UP) { const int e = r >> 9, kb = ((r >> 6) & 7) * 2 + (r & 1), nb = (r >> 1) & 31, n0 = nb * 64,     j0 = n0 & 1023, lin = n0 >> 10;
        c.W = F.w_up + (size_t)e * D * 2 * DFF; c.ks = F.norm_ffn; c.kf = 1.f; c.WT = (unsigned char*)F.WUP + (size_t)e * 2 * DFF * D * (MOE_FP8 ? 1 : 2); c.ldw = 2 * DFF; c.K = D; c.k0 = kb * 64; c.n0 = n0; c.drow0 = 256 * (j0 >> 7) + 128 * lin + (j0 & 127); }
    else { r -= I_UP; const int e = r >> 8, kb = ((r >> 5) & 7) * 2 + (r & 1), nb = (r >> 1) & 15;
        c.W = F.w_down + (size_t)e * DFF * D; c.ks = F.norm_ffn; c.kf = 0.f; c.WT = (unsigned char*)F.WDN + (size_t)e * D * DFF * (MOE_FP8 ? 1 : 2); c.ldw = D; c.K = DFF; c.k0 = kb * 64; c.n0 = nb * 64; c.drow0 = nb * 64; }
    return c;
}
#if MOE_FP8
struct CvtRegs { f32x4 v[4][4]; };
__device__ __forceinline__ void cvt_load(const CvtItem& c, CvtRegs& R, int lane) {
    const int q = lane >> 4, a = lane & 15;
#pragma unroll
    for (int i = 0; i < 4; ++i)
#pragma unroll
        for (int r = 0; r < 4; ++r) R.v[i][r] = __builtin_nontemporal_load((const f32x4*)(c.W + (size_t)(c.k0 + 16 * i + 4 * q + r) * c.ldw + c.n0 + 4 * a));
}
__device__ __forceinline__ void cvt_finish(const CvtItem& c, const CvtRegs& R, LAS unsigned* scr, int lane) {
    const int q = lane >> 4, a = lane & 15;
#pragma unroll
    for (int i = 0; i < 4; ++i)
#pragma unroll
        for (int j = 0; j < 4; ++j) scr[(4 * a + j) * 17 + 4 * i + q] = pk4_fp8(R.v[i][0][j] * 64.f, R.v[i][1][j] * 64.f, R.v[i][2][j] * 64.f, R.v[i][3][j] * 64.f);
    asm volatile("s_waitcnt lgkmcnt(0)" ::: "memory");
    const int cc = lane & 3;
#pragma unroll
    for (int i2 = 0; i2 < 4; ++i2) { const int row = (lane >> 2) + 16 * i2; u32x4 o;
        o.x = scr[row * 17 + 4 * cc]; o.y = scr[row * 17 + 4 * cc + 1]; o.z = scr[row * 17 + 4 * cc + 2]; o.w = scr[row * 17 + 4 * cc + 3];
        *(u32x4*)(c.WT + (size_t)(c.drow0 + row) * c.K + c.k0 + 16 * cc) = o; }
    asm volatile("s_waitcnt lgkmcnt(0)" ::: "memory");
}
__device__ __forceinline__ void cvt_run(Frame& F, int first, int stride, int n, LAS unsigned* scr) {
    CvtRegs Ra, Rb, Rc; CvtItem ca = cvt_decode(F, first), cb = ca, cc = ca;
    cvt_load(ca, Ra, F.lane);
    if (n > 1) { cb = cvt_decode(F, first + stride); cvt_load(cb, Rb, F.lane); }
    for (int j = 0; j < n; j += 3) {
        if (j + 2 < n) { cc = cvt_decode(F, first + (j + 2) * stride); cvt_load(cc, Rc, F.lane); }
        cvt_finish(ca, Ra, scr, F.lane);
        if (j + 3 < n) { ca = cvt_decode(F, first + (j + 3) * stride); cvt_load(ca, Ra, F.lane); }
        if (j + 1 < n) cvt_finish(cb, Rb, scr, F.lane);
        if (j + 4 < n) { cb = cvt_decode(F, first + (j + 4) * stride); cvt_load(cb, Rb, F.lane); }
        if (j + 2 < n) cvt_finish(cc, Rc, scr, F.lane);
    }
}
#endif
__device__ __forceinline__ void cvt_expert_item(Frame& F, int r, LAS unsigned* scr) {
    const CvtItem c = cvt_decode(F, r);
#if MOE_FP8
    p0_tr_item8(c.W, c.ldw, c.K, nullptr, 64.f, c.WT, c.k0, c.n0, c.drow0, scr, F.lane);
#else
    p0_tr_item(c.W, c.ldw, c.K, c.kf != 0.f ? c.ks : nullptr, (bf16_t*)c.WT, c.k0, c.n0, c.drow0, scr, F.lane);
#endif
}
__device__ __forceinline__ void cvt_expert_items(Frame& F, int part = 0, int nparts = 1, int pend = -1) {
    LAS unsigned* scr = (LAS unsigned*)(F.lds + F.wave * 8448);
#if MOE_FP8
    if (F.G == 256) {
        int first, stride, n;
        if (F.bid < S5G) { first = F.bid * 8 + F.wave; stride = 256; n = 8; }
        else { const int w = (F.bid - S5G) * 8 + F.wave, NW = (256 - S5G) * 8, total = I_UP + I_DN - 2048; first = 2048 + w; stride = NW; n = total / NW + (w < total % NW ? 1 : 0); }
        const int j0 = n * part / nparts, j1 = n * (pend < 0 ? part + 1 : pend) / nparts;
        if (j1 > j0) cvt_run(F, first + j0 * stride, stride, j1 - j0, scr);
        return; }
#endif
    if (part == 0) for (int r = F.bid * NWAVES + F.wave; r < I_UP + I_DN; r += F.G * NWAVES) cvt_expert_item(F, r, scr);
}

__device__ __forceinline__ void cvt_expert_queue(Frame& F, unsigned* queue) {
#if MOE_FP8
    LAS unsigned* scr = (LAS unsigned*)(F.lds + F.wave * 8448);
    for (;;) {
        unsigned r = 0; if (F.lane == 0) r = atomicAdd(queue, 4u);
        r = (unsigned)__builtin_amdgcn_readfirstlane((int)r);
        if (r >= (unsigned)(I_UP + I_DN)) break;
        cvt_run(F, (int)r, 1, 4, scr);
    }
#else
    cvt_expert_items(F);
#endif
}

struct SchedP1 {
    int G, c; const char* XB; const char* WIN; int i0, i1;
    __device__ __forceinline__ bool next(int i, pg::GUnit& u) const {
        i += i0; if (i >= i1) return false;
        const int L = i * G + c; if (L >= 1024) return false;
        u.A2 = nullptr; u.list = nullptr; u.x1 = 0; u.nvalid = 256;
        if (L < 896) { const int w = (L & 7) * 112 + (L >> 3), gid = w / 112, rem = w % 112; u.pm = gid * 8 + (rem & 7); u.pn = rem >> 3; u.x0 = 0;
            u.A = XB + (size_t)u.pm * 256 * 2048; u.B = WIN + (size_t)u.pn * 256 * 2048; }
        else { const int l = L - 896; u.pm = l >> 6; u.pn = l & 63; u.x0 = 1; u.A = WIN + (size_t)(3584 + u.pm * 256) * 2048; u.B = XB + (size_t)u.pn * 256 * 2048; }
        return true;
    }
};
struct EpiInProj {
    static constexpr bool PERM = true;
    const float* rstd1; bf16_t *QB, *KB, *UB, *GSB, *GS5, *VT;
    __device__ __forceinline__ void operator()(const f32x4 (&acc)[2][2][4][2], const pg::GUnit& u, int wr, int wc, int fr, int fq) const {
        if (u.x0 == 0) {
            bf16_t* base; int ld, colt, mode; const int pn = u.pn; bool gm = false;
            if (pn < 2) { base = QB; ld = SBW; colt = pn * 256; mode = 1; }
            else if (pn < 4) { base = KB; ld = SBW; colt = (pn - 2) * 256; mode = 0; }
            else if (pn < 6) { base = UB; ld = S5H; colt = (pn - 4) * 256; mode = 0; gm = true; }
            else if (pn < 10) { base = GSB; ld = D; colt = (pn - 6) * 256; mode = 2; }
            else { base = GS5; ld = D; colt = (pn - 10) * 256; mode = 2; }
            const int row0 = u.pm * 256 + wr * 64 + fr, col0 = colt + wc * 32 + 8 * fq;
            const size_t coff = gm ? (size_t)(col0 >> 4) * T * S5H + (col0 & 15) : (size_t)col0; const size_t bjstep = gm ? (size_t)8 * T * S5H : (size_t)128;
            float rsv[2][4];
#pragma unroll
            for (int ai = 0; ai < 2; ++ai)
#pragma unroll
                for (int m = 0; m < 4; ++m) rsv[ai][m] = rstd1[row0 + ai * 128 + m * 16];
#pragma unroll
            for (int ai = 0; ai < 2; ++ai)
#pragma unroll
                for (int m = 0; m < 4; ++m) { const int row = row0 + ai * 128 + m * 16; float rs = rsv[ai][m]; if (mode == 1) rs *= C2;
                    bf16_t* rowp = base + (size_t)row * ld + coff;
#pragma unroll
                    for (int bj = 0; bj < 2; ++bj) { f32x4 v0 = acc[ai][bj][m][0] * rs, v1 = acc[ai][bj][m][1] * rs;
                        if (mode == 2) {
#pragma unroll
                            for (int j = 0; j < 4; ++j) { v0[j] = fast_sigmoid(v0[j]); v1[j] = fast_sigmoid(v1[j]); } }
                        u32x4 w; w.x = cvt_pk_bf16(v0[0], v0[1]); w.y = cvt_pk_bf16(v0[2], v0[3]); w.z = cvt_pk_bf16(v1[0], v1[1]); w.w = cvt_pk_bf16(v1[2], v1[3]);
                        *(u32x4*)(rowp + bj * bjstep) = w; } }
        } else {
            const int row0 = u.pm * 256 + wr * 64 + fr, col0 = u.pn * 256 + wc * 32 + 8 * fq;
            f32x4 rs[2][2];
#pragma unroll
            for (int bj = 0; bj < 2; ++bj) { rs[bj][0] = *(const f32x4*)(rstd1 + col0 + bj * 128); rs[bj][1] = *(const f32x4*)(rstd1 + col0 + bj * 128 + 4); }
#pragma unroll
            for (int ai = 0; ai < 2; ++ai)
#pragma unroll
                for (int m = 0; m < 4; ++m) { bf16_t* rowp = VT + (size_t)(row0 + ai * 128 + m * 16) * T + col0;
#pragma unroll
                    for (int bj = 0; bj < 2; ++bj) { const f32x4 v0 = acc[ai][bj][m][0] * rs[bj][0], v1 = acc[ai][bj][m][1] * rs[bj][1];
                        u32x4 w; w.x = cvt_pk_bf16(v0[0], v0[1]); w.y = cvt_pk_bf16(v0[2], v0[3]); w.z = cvt_pk_bf16(v1[0], v1[1]); w.w = cvt_pk_bf16(v1[2], v1[3]);
                        *(u32x4*)(rowp + bj * 128) = w; } }
        }
    }
};
namespace pg {
struct SrcS5 {
    static constexpr bool A_PER_UNIT = false;
    int ntA, nt2, KBl;
    __device__ __forceinline__ int nt() const { return ntA + nt2; }
    __device__ __forceinline__ const char* a_tile(const GUnit& u, int t) const { return t < ntA ? u.A + (size_t)t * 128 : u.A2 + (size_t)(t - ntA) * 128; }
    __device__ __forceinline__ const char* b_tile(const GUnit& u, int t) const { return u.B + (size_t)t * (BK * 2); }
    __device__ __forceinline__ unsigned a_off(const GUnit&, int R, int C) const { return (unsigned)(R * 512 + C * 2); }
    __device__ __forceinline__ unsigned b_off(int R, int C) const { return (unsigned)(R * KBl + C) * 2u; }
    __device__ __forceinline__ size_t b_hstep() const { return (size_t)HALF * KBl * 2; }
};
}
struct SchedS5 {
    int G, c; const char *UB, *SIN, *Bm; size_t bstride;
    __device__ __forceinline__ bool next(int i, pg::GUnit& u) const {
        const int L = c; if (i > 0 || L >= 128) return false;
        const int g = ((L & 7) << 2) | ((L >> 3) & 3)  , mt = L >> 5; u.pm = mt; u.pn = 0; u.x0 = g; u.x1 = 0; u.nvalid = 256; u.list = nullptr;
        u.A = UB + ((size_t)g * T * 32 + (size_t)mt * 256 * 512); u.A2 = SIN + ((size_t)g * NCHUNK + (size_t)mt * 256) * 512; u.B = Bm + (size_t)g * bstride; return true;
    }
};
struct EpiSloc {
    static constexpr bool PERM = false; float* SLOC;
    __device__ __forceinline__ void operator()(const f32x4 (&acc)[2][2][4][2], const pg::GUnit& u, int wr, int wc, int fr, int fq) const {
#pragma unroll
        for (int ai = 0; ai < 2; ++ai)
#pragma unroll
            for (int m = 0; m < 4; ++m) { const int chunk = u.pm * 256 + ai * 128 + wr * 64 + m * 16 + fr; float* rowp = SLOC + ((size_t)chunk * S5G + u.x0) * 128 + wc * 32 + 4 * fq;
#pragma unroll
                for (int n = 0; n < 2; ++n) *(f32x4*)(rowp + 16 * n) = acc[ai][0][m][n]; }
    }
};
struct EpiY {
    static constexpr bool PERM = true; bf16_t* Y2;
    __device__ __forceinline__ void operator()(const f32x4 (&acc)[2][2][4][2], const pg::GUnit& u, int wr, int wc, int fr, int fq) const {
#pragma unroll
        for (int ai = 0; ai < 2; ++ai)
#pragma unroll
            for (int m = 0; m < 4; ++m) { const int chunk = u.pm * 256 + ai * 128 + wr * 64 + m * 16 + fr;
#pragma unroll
                for (int bj = 0; bj < 2; ++bj) { const int c = bj * 128 + wc * 32 + 8 * fq, i = c >> 4, h0 = c & 15; const f32x4 v0 = acc[ai][bj][m][0], v1 = acc[ai][bj][m][1];
                    u32x4 w; w.x = cvt_pk_bf16(gelu_tanh(v0[0]), gelu_tanh(v0[1])); w.y = cvt_pk_bf16(gelu_tanh(v0[2]), gelu_tanh(v0[3])); w.z = cvt_pk_bf16(gelu_tanh(v1[0]), gelu_tanh(v1[1])); w.w = cvt_pk_bf16(gelu_tanh(v1[2]), gelu_tanh(v1[3]));
                    *(u32x4*)(Y2 + ((size_t)chunk * LC + i) * S5W + u.x0 * S5H + h0) = w; } }
    }
};
__device__ __forceinline__ void p3_scan(Frame& F) {
    if (F.bid >= NB * S5G) return;
    __builtin_amdgcn_fence(__ATOMIC_ACQUIRE, "agent"); asm volatile("s_waitcnt vmcnt(0)" ::: "memory");
    const int b = F.bid >> 5, g = ((F.bid & 7) << 2) | ((F.bid >> 3) & 3), p = F.lane, w = F.wave;
    float lr, li; cpow_lam(F.lam_re[g * S5P + p], F.lam_im[g * S5P + p], expf(F.log_step[g]), lr, li);
#pragma unroll
    for (int s = 0; s < 4; ++s) { const float nr = lr * lr - li * li, ni = 2.f * lr * li; lr = nr; li = ni; }
    const float* sl = F.SLOC + ((size_t)(b * 256 + 32 * w) * S5G + g) * 128 + p;
    float ar[32], ai[32];
#pragma unroll
    for (int j = 0; j < 32; ++j) { ar[j] = sl[(size_t)j * S5G * 128]; ai[j] = sl[(size_t)j * S5G * 128 + 64]; }
    float er = 0.f, ei = 0.f;
#pragma unroll
    for (int j = 0; j < 32; ++j) { const float nr = lr * er - li * ei + ar[j], ni = lr * ei + li * er + ai[j]; er = nr; ei = ni; }
    LAS float* es = (LAS float*)F.lds;
    es[(w * 2) * 64 + p] = er; es[(w * 2 + 1) * 64 + p] = ei;
    float br = lr, bi = li;
#pragma unroll
    for (int s = 0; s < 5; ++s) { const float nr = br * br - bi * bi, ni = 2.f * br * bi; br = nr; bi = ni; }
    __syncthreads();
    float sr = 0.f, si = 0.f;
    for (int w2 = 0; w2 < w; ++w2) { const float xr = es[(w2 * 2) * 64 + p], xi = es[(w2 * 2 + 1) * 64 + p]; const float nr = br * sr - bi * si + xr, ni = br * si + bi * sr + xi; sr = nr; si = ni; }
    bf16_t* so = F.SIN + ((size_t)g * NCHUNK + b * 256 + 32 * w) * 256;
#pragma unroll
    for (int j = 0; j < 32; ++j) { bf16_t* o = so + (size_t)j * 256;
        o[p] = f2bf(sr); o[64 + p] = f2bf(si);
        const float nr = lr * sr - li * si + ar[j], ni = lr * si + li * sr + ai[j]; sr = nr; si = ni; }
    asm volatile("s_waitcnt vmcnt(0)" ::: "memory");
    __syncthreads();
    __builtin_amdgcn_fence(__ATOMIC_ACQUIRE, "agent"); asm volatile("s_waitcnt vmcnt(0)" ::: "memory");
}
struct SchedTiles {
    int G, c, nM, nN, passes; const char *A0, *A1, *B0, *B1; size_t arow, brow;
    __device__ __forceinline__ bool next(int i, pg::GUnit& u) const {
        const int tile = c + (i / passes) * G, pass = i % passes, nwg = nM * nN; if (tile >= nwg) return false;
        int w = tile; if ((nwg & 7) == 0) w = (tile & 7) * (nwg >> 3) + (tile >> 3);
        const int nig = 8 * nN, gid = w / nig, rem = w % nig, fm = gid * 8, gsz = (nM - fm) < 8 ? (nM - fm) : 8;
        u.pm = fm + rem % gsz; u.pn = rem / gsz; u.x0 = pass; u.x1 = 0; u.nvalid = 256; u.list = nullptr; u.A2 = nullptr;
        u.A = (pass ? A1 : A0) + (size_t)u.pm * arow; u.B = (pass ? B1 : B0) + (size_t)u.pn * brow; return true;
    }
};
struct SchedOne {
    int pm, pn; const char* A; const char* B;
    __device__ __forceinline__ bool next(int i, pg::GUnit& u) const { if (i > 0) return false; u.pm = pm; u.pn = pn; u.x0 = 0; u.x1 = 0; u.nvalid = 256; u.list = nullptr; u.A2 = nullptr; u.A = A; u.B = B; return true; }
};
struct EpiGlu {
    static constexpr bool PERM = true; const bf16_t* Y2; bf16_t* YS5;
    __device__ __forceinline__ void operator()(const f32x4 (&acc)[2][2][4][2], const pg::GUnit& u, int wr, int wc, int fr, int fq) const {
#pragma unroll
        for (int ai = 0; ai < 2; ++ai) { u32x4 yv[4][2];
#pragma unroll
            for (int m = 0; m < 4; ++m)
#pragma unroll
                for (int bj = 0; bj < 2; ++bj) yv[m][bj] = *(const u32x4*)(Y2 + (size_t)(u.pm * 256 + ai * 128 + wr * 64 + m * 16 + fr) * S5W + u.pn * 256 + bj * 128 + wc * 32 + 8 * fq);
#pragma unroll
            for (int m = 0; m < 4; ++m)
#pragma unroll
                for (int bj = 0; bj < 2; ++bj) { const size_t off = (size_t)(u.pm * 256 + ai * 128 + wr * 64 + m * 16 + fr) * S5W + u.pn * 256 + bj * 128 + wc * 32 + 8 * fq; const u32x4 y = yv[m][bj]; const f32x4 v0 = acc[ai][bj][m][0], v1 = acc[ai][bj][m][1];
                    u32x4 w; w.x = cvt_pk_bf16(bflo(y.x) * fast_sigmoid(v0[0]), bfhi(y.x) * fast_sigmoid(v0[1])); w.y = cvt_pk_bf16(bflo(y.y) * fast_sigmoid(v0[2]), bfhi(y.y) * fast_sigmoid(v0[3]));
                    w.z = cvt_pk_bf16(bflo(y.z) * fast_sigmoid(v1[0]), bfhi(y.z) * fast_sigmoid(v1[1])); w.w = cvt_pk_bf16(bflo(y.w) * fast_sigmoid(v1[2]), bfhi(y.w) * fast_sigmoid(v1[3]));
                    *(u32x4*)(YS5 + off) = w; } }
    }
};
struct EpiMerge {
    static constexpr bool PERM = true; const bf16_t *GSB, *GS5; bf16_t* MRG;
    __device__ __forceinline__ void operator()(const f32x4 (&acc)[2][2][4][2], const pg::GUnit& u, int wr, int wc, int fr, int fq) const {
        const bf16_t* gate = u.x0 ? GS5 : GSB;
#pragma unroll
        for (int ai = 0; ai < 2; ++ai) { u32x4 gv[4][2], pv[4][2];
#pragma unroll
            for (int m = 0; m < 4; ++m)
#pragma unroll
                for (int bj = 0; bj < 2; ++bj) { const size_t off = (size_t)(u.pm * 256 + ai * 128 + wr * 64 + m * 16 + fr) * D + u.pn * 256 + bj * 128 + wc * 32 + 8 * fq; gv[m][bj] = *(const u32x4*)(gate + off); pv[m][bj] = u.x0 ? *(const u32x4*)(MRG + off) : (u32x4){0u, 0u, 0u, 0u}; }
#pragma unroll
            for (int m = 0; m < 4; ++m)
#pragma unroll
                for (int bj = 0; bj < 2; ++bj) { const size_t off = (size_t)(u.pm * 256 + ai * 128 + wr * 64 + m * 16 + fr) * D + u.pn * 256 + bj * 128 + wc * 32 + 8 * fq; const u32x4 gt = gv[m][bj], pp = pv[m][bj]; const f32x4 v0 = acc[ai][bj][m][0], v1 = acc[ai][bj][m][1];
                    const float o[8] = {bflo(gt.x) * v0[0] + bflo(pp.x), bfhi(gt.x) * v0[1] + bfhi(pp.x), bflo(gt.y) * v0[2] + bflo(pp.y), bfhi(gt.y) * v0[3] + bfhi(pp.y), bflo(gt.z) * v1[0] + bflo(pp.z), bfhi(gt.z) * v1[1] + bfhi(pp.z), bflo(gt.w) * v1[2] + bflo(pp.w), bfhi(gt.w) * v1[3] + bfhi(pp.w)};
                    u32x4 w; w.x = cvt_pk_bf16(o[0], o[1]); w.y = cvt_pk_bf16(o[2], o[3]); w.z = cvt_pk_bf16(o[4], o[5]); w.w = cvt_pk_bf16(o[6], o[7]);
                    *(u32x4*)(MRG + off) = w; } }
    }
};
struct EpiOut {
    static constexpr bool PERM = true; const bf16_t* x; bf16_t* X1; bf16_t* X1B; float* SS2P; const float* gffn;
    __device__ __forceinline__ void operator()(const f32x4 (&acc)[2][2][4][2], const pg::GUnit& u, int wr, int wc, int fr, int fq) const {
        float ss[2][4];
#pragma unroll
        for (int ai = 0; ai < 2; ++ai)
#pragma unroll
            for (int m = 0; m < 4; ++m) ss[ai][m] = 0.f;
#pragma unroll
        for (int bj = 0; bj < 2; ++bj) { const int col = u.pn * 256 + bj * 128 + wc * 32 + 8 * fq; const f32x4 g0 = *(const f32x4*)(gffn + col), g1 = *(const f32x4*)(gffn + col + 4);
#pragma unroll
            for (int ai = 0; ai < 2; ++ai) { u32x4 xv[4];
#pragma unroll
                for (int m = 0; m < 4; ++m) { const size_t off = (size_t)(u.pm * 256 + ai * 128 + wr * 64 + m * 16 + fr) * D + col; xv[m] = *(const u32x4*)(x + off); }
#pragma unroll
                for (int m = 0; m < 4; ++m) { const size_t off = (size_t)(u.pm * 256 + ai * 128 + wr * 64 + m * 16 + fr) * D + col;
                    const f32x4 o0 = (f32x4){bflo(xv[m].x), bfhi(xv[m].x), bflo(xv[m].y), bfhi(xv[m].y)} + acc[ai][bj][m][0], o1 = (f32x4){bflo(xv[m].z), bfhi(xv[m].z), bflo(xv[m].w), bfhi(xv[m].w)} + acc[ai][bj][m][1];
                    { u32x4 wb; wb.x = cvt_pk_bf16(o0[0], o0[1]); wb.y = cvt_pk_bf16(o0[2], o0[3]); wb.z = cvt_pk_bf16(o1[0], o1[1]); wb.w = cvt_pk_bf16(o1[2], o1[3]); *(u32x4*)(X1 + off) = wb; }
#if MOE_FP8
                    const f32x4 p0 = o0 * g0, p1 = o1 * g1; u32x2 w8; w8.x = pk4_fp8(p0[0], p0[1], p0[2], p0[3]); w8.y = pk4_fp8(p1[0], p1[1], p1[2], p1[3]); *(u32x2*)((unsigned char*)X1B + off) = w8;
#else
                    u32x4 w; w.x = cvt_pk_bf16(o0[0], o0[1]); w.y = cvt_pk_bf16(o0[2], o0[3]); w.z = cvt_pk_bf16(o1[0], o1[1]); w.w = cvt_pk_bf16(o1[2], o1[3]);
                    *(u32x4*)(X1B + off) = w;
#endif
                    ss[ai][m] += (o0[0] * o0[0] + o0[1] * o0[1]) + (o0[2] * o0[2] + o0[3] * o0[3]) + (o1[0] * o1[0] + o1[1] * o1[1]) + (o1[2] * o1[2] + o1[3] * o1[3]); } } }
#pragma unroll
        for (int ai = 0; ai < 2; ++ai)
#pragma unroll
            for (int m = 0; m < 4; ++m) { float s = ss[ai][m]; s += __shfl_xor(s, 16); s += __shfl_xor(s, 32);
                if (fq == 0) SS2P[(size_t)(u.pm * 256 + ai * 128 + wr * 64 + m * 16 + fr) * 16 + u.pn * 4 + wc] = s; }
    }
};
__device__ __forceinline__ int crow(int r, int hi) { return (r & 3) + 8 * (r >> 2) + 4 * hi; }
__device__ __forceinline__ void p8_router(Frame& F, unsigned* cntw, int* LISTp, float* GATELp, float* RS2Lp) {
    const int lane = F.lane, r32 = lane & 31, hi = lane >> 5, rg = F.wave >> 2, kq = F.wave & 3;
    LAS float* part = (LAS float*)F.lds;
    LAS unsigned* wl = (LAS unsigned*)(F.lds + 32768 + F.wave * 256);
    for (int bu = F.bid; bu < T / 64; bu += F.G) {
        const int row = bu * 64 + rg * 32 + r32;
        const bf16_t* xr = F.X1BF + (size_t)row * D + kq * 256 + 8 * hi;
        const bf16_t* wh = F.WR + (size_t)r32 * D + kq * 256 + 8 * hi; const bf16_t* wlo = wh + NE * D;
        f32x16 acc = {};
#pragma unroll 8
        for (int s = 0; s < 16; ++s) {
            const bf16x8 bh = *(const bf16x8*)(xr + 16 * s);
            const bf16x8 ah = *(const bf16x8*)(wh + 16 * s), al = *(const bf16x8*)(wlo + 16 * s);
            acc = __builtin_amdgcn_mfma_f32_32x32x16_bf16(ah, bh, acc, 0, 0, 0);
            acc = __builtin_amdgcn_mfma_f32_32x32x16_bf16(al, bh, acc, 0, 0, 0);
        }
#pragma unroll
        for (int i = 0; i < 16; ++i) part[(F.wave * 16 + i) * 64 + lane] = acc[i];
        __syncthreads();
        if (kq == 0) {
#pragma unroll
            for (int i = 0; i < 16; ++i) acc[i] = ((part[((F.wave + 0) * 16 + i) * 64 + lane] + part[((F.wave + 1) * 16 + i) * 64 + lane]) + part[((F.wave + 2) * 16 + i) * 64 + lane]) + part[((F.wave + 3) * 16 + i) * 64 + lane];
            float ss = 0.f;
#pragma unroll
            for (int j = 0; j < 4; ++j) { const f32x4 p = *(const f32x4*)(F.SS2P + (size_t)row * 16 + 4 * j); ss += (p[0] + p[1]) + (p[2] + p[3]); }
            const float rs = rsqrtf(ss * (1.0f / D) + RMS_EPS);
            if (hi == 0) F.RSTD2[row] = rs;
            float lg[NE];
#pragma unroll
            for (int i = 0; i < 16; ++i) { const float own = acc[i], oth = __shfl_xor(own, 32); const float v0 = hi ? oth : own, v1 = hi ? own : oth;
                lg[crow(i, 0)] = rs * v0 + F.b_router[crow(i, 0)]; lg[crow(i, 1)] = rs * v1 + F.b_router[crow(i, 1)]; }
            int idx[TOPK]; float val[TOPK];
#pragma unroll
            for (int k = 0; k < TOPK; ++k) { float best = -INFINITY; int bi = 0;
#pragma unroll
                for (int e = 0; e < NE; ++e) { bool taken = false;
#pragma unroll
                    for (int kk = 0; kk < k; ++kk) taken |= (idx[kk] == e);
                    if (!taken && lg[e] > best) { best = lg[e]; bi = e; } }
                idx[k] = bi; val[k] = best; }
            float w[TOPK], sum = 0.f;
#pragma unroll
            for (int k = 0; k < TOPK; ++k) { w[k] = __expf(val[k] - val[0]); sum += w[k]; }
            const float inv = 1.0f / sum;
            if (lane < 32) wl[lane] = 0u;
            asm volatile("s_waitcnt lgkmcnt(0)" ::: "memory");
            unsigned rank[TOPK];
#pragma unroll
            for (int k = 0; k < TOPK; ++k) rank[k] = (hi == 0) ? __hip_atomic_fetch_add((LAS unsigned*)wl + idx[k], 1u, __ATOMIC_RELAXED, __HIP_MEMORY_SCOPE_WORKGROUP) : 0u;
            asm volatile("s_waitcnt lgkmcnt(0)" ::: "memory");
            if (lane < 32) { const unsigned c = wl[lane]; unsigned base = 0u; if (c) base = atomicAdd(cntw + 64 * lane, c); wl[32 + lane] = base; }
            asm volatile("s_waitcnt vmcnt(0) lgkmcnt(0)" ::: "memory");
            if (hi == 0) {
#pragma unroll
                for (int k = 0; k < TOPK; ++k) { const unsigned pos = wl[32 + idx[k]] + rank[k]; LISTp[(size_t)idx[k] * T + pos] = row * 4 + k; GATELp[(size_t)idx[k] * T + pos] = w[k] * inv; RS2Lp[(size_t)idx[k] * T + pos] = rs; }
            }
            asm volatile("s_waitcnt lgkmcnt(0)" ::: "memory");
        }
        __syncthreads();
    }
}
__device__ __forceinline__ void moe_prefix(Frame& F) {
    if (F.tid < NE) F.MISC[64 + F.tid] = __hip_atomic_load(F.ctl + CW_CNT + 64 * F.tid, __ATOMIC_RELAXED, __HIP_MEMORY_SCOPE_AGENT);
    __syncthreads();
    if (F.tid == 0) { int accp = 0; for (int e = 0; e < NE; ++e) { F.MISC[16 + e] = (unsigned)accp; accp += (int)((F.MISC[64 + e] + 255u) >> 8); } F.MISC[16 + NE] = (unsigned)accp; }
    __syncthreads();
}
struct SchedMoe {
    int sb_off, rt_hi, single;
    int G, c, nper, tpre, tcnt; const int* LIST; const float* FMETA; const char* Abase; const char* Bbase; size_t bexp, atile, btile; bool gather; const float* BIAS;
    __device__ __forceinline__ void load_tables(const LAS unsigned* pre, int lane) { tpre = (int)pre[lane < 33 ? lane : 32]; tcnt = (int)pre[48 + (lane & 31)]; }
    __device__ __forceinline__ int total_rt() const { return __builtin_amdgcn_readlane(tpre, NE); }
    __device__ __forceinline__ bool next(int i, pg::GUnit& u) const {
        int rt, nt;
        if (single && i > 0) return false;
        if ((G & 255) == 0) { const int cc = c & 255, x = cc & 7, s = cc >> 3, rpb = 32 / nper, sb = sb_off + (i * (G >> 8) + (c >> 8)) * 8 + x; rt = sb * rpb + s / nper; nt = s % nper; }
        else { const int L = i * G + c; rt = L / nper; nt = L % nper; }
        if (rt >= rt_hi) return false;
        int e = 0, hi_ = NE - 1;
#pragma unroll
        for (int it = 0; it < 5; ++it) { const int mid = (e + hi_ + 1) >> 1; const int pm_ = __builtin_amdgcn_readlane(tpre, mid); if (pm_ <= rt) e = mid; else hi_ = mid - 1; }
        const int pe = __builtin_amdgcn_readlane(tpre, e);
        const int mt = rt - pe, cnt = __builtin_amdgcn_readlane(tcnt, e);
        u.x0 = e; u.x1 = rt * 256; u.pm = mt; u.pn = nt; u.nvalid = (cnt - mt * 256) < 256 ? (cnt - mt * 256) : 256; u.list = LIST + (size_t)e * T + mt * 256; u.A2 = (const char*)(FMETA + (size_t)e * T + mt * 256);
        u.A = gather ? Abase : Abase + (size_t)rt * atile; u.B = Bbase + (size_t)e * bexp + (size_t)nt * btile;
        if (gather) { u.bias = BIAS + (size_t)e * 2 * DFF + 128 * nt; u.bstep = DFF; } else { u.bias = BIAS + (size_t)e * D + 256 * nt; u.bstep = 128; }
        return true;
    }
};
struct EpiUp {
    static constexpr bool PERM = true; const float *RSTD2, *b_up; bf16_t* ACT;
    __device__ __forceinline__ void operator()(const f32x4 (&acc)[2][2][4][2], const pg::GUnit& u, int wr, int wc, int fr, int fq) const {
        const int j0 = 128 * u.pn + 32 * wc + 8 * fq; const float* bu = b_up + (size_t)u.x0 * 2 * DFF + j0;
        const f32x4 bg0 = *(const f32x4*)bu, bg1 = *(const f32x4*)(bu + 4), bl0 = *(const f32x4*)(bu + DFF), bl1 = *(const f32x4*)(bu + DFF + 4);
        float rsv[2][4]; const float* rl = RSTD2 + (size_t)u.x0 * T + u.pm * 256;
#pragma unroll
        for (int ai = 0; ai < 2; ++ai)
#pragma unroll
            for (int m = 0; m < 4; ++m) { const int r = ai * 128 + wr * 64 + m * 16 + fr; rsv[ai][m] = rl[r < u.nvalid ? r : 0]; }
#pragma unroll
        for (int ai = 0; ai < 2; ++ai)
#pragma unroll
            for (int m = 0; m < 4; ++m) { const int r = ai * 128 + wr * 64 + m * 16 + fr; if (r < u.nvalid) { const float rs = rsv[ai][m];
                const f32x4 g0 = acc[ai][0][m][0] * rs + bg0, g1 = acc[ai][0][m][1] * rs + bg1, l0 = acc[ai][1][m][0] * rs + bl0, l1 = acc[ai][1][m][1] * rs + bl1; float o[8];
#pragma unroll
                for (int q = 0; q < 4; ++q) { const float ga = fminf(g0[q], LIMIT), gb = fminf(g1[q], LIMIT), la = fminf(fmaxf(l0[q], -LIMIT), LIMIT), lb = fminf(fmaxf(l1[q], -LIMIT), LIMIT);
                    o[q] = ga * fast_sigmoid(ALPHA * ga) * (la + 1.0f); o[4 + q] = gb * fast_sigmoid(ALPHA * gb) * (lb + 1.0f); }
#if MOE_FP8
                u32x2 w8; w8.x = pk4_fp8(o[0], o[1], o[2], o[3]); w8.y = pk4_fp8(o[4], o[5], o[6], o[7]); *(u32x2*)((unsigned char*)ACT + (size_t)(u.x1 + r) * DFF + j0) = w8; } }
#else
                u32x4 w; w.x = cvt_pk_bf16(o[0], o[1]); w.y = cvt_pk_bf16(o[2], o[3]); w.z = cvt_pk_bf16(o[4], o[5]); w.w = cvt_pk_bf16(o[6], o[7]);
                *(u32x4*)(ACT + (size_t)(u.x1 + r) * DFF + j0) = w; } }
#endif
    }
};
struct EpiDown {
    static constexpr bool PERM = true; const float *GATEL, *b_down; bf16_t* YSLOT;
    __device__ __forceinline__ void operator()(const f32x4 (&acc)[2][2][4][2], const pg::GUnit& u, int wr, int wc, int fr, int fq) const {
        const int c0 = 256 * u.pn + 32 * wc + 8 * fq; const float* bd = b_down + (size_t)u.x0 * D + c0;
        f32x4 bv[2][2];
#pragma unroll
        for (int bj = 0; bj < 2; ++bj) { bv[bj][0] = *(const f32x4*)(bd + bj * 128); bv[bj][1] = *(const f32x4*)(bd + bj * 128 + 4); }
        const float* gl = GATEL + (size_t)u.x0 * T + u.pm * 256;
        int slv[2][4]; float gtv[2][4];
#pragma unroll
        for (int ai = 0; ai < 2; ++ai)
#pragma unroll
            for (int m = 0; m < 4; ++m) { const int r = ai * 128 + wr * 64 + m * 16 + fr, rr = r < u.nvalid ? r : 0; slv[ai][m] = u.list[rr]; gtv[ai][m] = gl[rr]; }
#pragma unroll
        for (int ai = 0; ai < 2; ++ai)
#pragma unroll
            for (int m = 0; m < 4; ++m) { const int r = ai * 128 + wr * 64 + m * 16 + fr; if (r < u.nvalid) { const float gt = gtv[ai][m]; bf16_t* rowp = YSLOT + (size_t)slv[ai][m] * D + c0;
#pragma unroll
                for (int bj = 0; bj < 2; ++bj) { const f32x4 v0 = (acc[ai][bj][m][0] + bv[bj][0]) * gt, v1 = (acc[ai][bj][m][1] + bv[bj][1]) * gt;
#if MOE_FP8
                    u32x2 w8; w8.x = pk4_fp8(v0[0] * 16.f, v0[1] * 16.f, v0[2] * 16.f, v0[3] * 16.f); w8.y = pk4_fp8(v1[0] * 16.f, v1[1] * 16.f, v1[2] * 16.f, v1[3] * 16.f);
                    *(u32x2*)((unsigned char*)YSLOT + (size_t)slv[ai][m] * D + c0 + bj * 128) = w8; } } }
#else
                    u32x4 w; w.x = cvt_pk_bf16(v0[0], v0[1]); w.y = cvt_pk_bf16(v0[2], v0[3]); w.z = cvt_pk_bf16(v1[0], v1[1]); w.w = cvt_pk_bf16(v1[2], v1[3]);
                    *(u32x4*)(rowp + bj * 128) = w; } } }
#endif
    }
};
struct EpiUpM {
    static constexpr bool PERM = true; const float* b_up; bf16_t* ACT;
    __device__ __forceinline__ void operator()(const f32x4 (&acc)[2][2][4][2], const pg::GUnit& u, int wr, int wc, int fr, int fq, LAS unsigned char* ms) const {
        const int j0 = 128 * u.pn + 32 * wc + 8 * fq; const LAS float* bs = (const LAS float*)(ms + 2048) + 32 * wc + 8 * fq;
        const f32x4 bg0 = *(const LAS f32x4*)bs, bg1 = *(const LAS f32x4*)(bs + 4), bl0 = *(const LAS f32x4*)(bs + 128), bl1 = *(const LAS f32x4*)(bs + 132);
        const LAS float* rl = (const LAS float*)(ms + 1024);
#pragma unroll
        for (int ai = 0; ai < 2; ++ai)
#pragma unroll
            for (int m = 0; m < 4; ++m) { const int r = ai * 128 + wr * 64 + m * 16 + fr; if (r < u.nvalid) { const float rs = rl[r];
                const f32x4 g0 = acc[ai][0][m][0] * rs + bg0, g1 = acc[ai][0][m][1] * rs + bg1, l0 = acc[ai][1][m][0] * rs + bl0, l1 = acc[ai][1][m][1] * rs + bl1; float o[8];
#pragma unroll
                for (int q = 0; q < 4; ++q) { const float ga = fminf(g0[q], LIMIT), gb = fminf(g1[q], LIMIT), la = fminf(fmaxf(l0[q], -LIMIT), LIMIT), lb = fminf(fmaxf(l1[q], -LIMIT), LIMIT);
                    o[q] = ga * fast_sigmoid(ALPHA * ga) * (la + 1.0f); o[4 + q] = gb * fast_sigmoid(ALPHA * gb) * (lb + 1.0f); }
                u32x2 w8; w8.x = pk4_fp8(o[0], o[1], o[2], o[3]); w8.y = pk4_fp8(o[4], o[5], o[6], o[7]); *(u32x2*)((unsigned char*)ACT + (size_t)(u.x1 + r) * DFF + j0) = w8; } }
    }
};
struct EpiDownM {
    static constexpr bool PERM = true; const float* b_down; bf16_t* YSLOT;
    __device__ __forceinline__ void operator()(const f32x4 (&acc)[2][2][4][2], const pg::GUnit& u, int wr, int wc, int fr, int fq, LAS unsigned char* ms) const {
        const int c0 = 256 * u.pn + 32 * wc + 8 * fq; const LAS float* bs = (const LAS float*)(ms + 2048) + 32 * wc + 8 * fq;
        f32x4 bv[2][2];
#pragma unroll
        for (int bj = 0; bj < 2; ++bj) { bv[bj][0] = *(const LAS f32x4*)(bs + bj * 128); bv[bj][1] = *(const LAS f32x4*)(bs + bj * 128 + 4); }
        const LAS int* sl = (const LAS int*)ms; const LAS float* gl = (const LAS float*)(ms + 1024);
#pragma unroll
        for (int ai = 0; ai < 2; ++ai)
#pragma unroll
            for (int m = 0; m < 4; ++m) { const int r = ai * 128 + wr * 64 + m * 16 + fr; if (r < u.nvalid) { const float gt = gl[r] * 16.f; unsigned char* rowp = (unsigned char*)YSLOT + (size_t)sl[r] * D + c0;
#pragma unroll
                for (int bj = 0; bj < 2; ++bj) { const f32x4 v0 = (acc[ai][bj][m][0] + bv[bj][0]) * gt, v1 = (acc[ai][bj][m][1] + bv[bj][1]) * gt;
                    u32x2 w8; w8.x = pk4_fp8(v0[0], v0[1], v0[2], v0[3]); w8.y = pk4_fp8(v1[0], v1[1], v1[2], v1[3]);
                    *(u32x2*)(rowp + bj * 128) = w8; } } }
    }
};
__device__ __forceinline__ void p11_row_load(const Frame& F, int m, f32x4 (&v)[4], unsigned (&y)[4][TOPK], int lane) {
    const u32x2* xr = (const u32x2*)(F.X1BF + (size_t)m * D) + lane;
#pragma unroll
    for (int j = 0; j < 4; ++j) { const u32x2 xb = xr[64 * j]; v[j] = (f32x4){bflo(xb.x), bfhi(xb.x), bflo(xb.y), bfhi(xb.y)};
#pragma unroll
        for (int k = 0; k < TOPK; ++k) {
#if MOE_FP8
            y[j][k] = __builtin_nontemporal_load((const unsigned*)((const unsigned char*)F.YSLOT + ((size_t)m * 4 + k) * D) + lane + 64 * j);
#else
            y[j][k] = 0u;
#endif
        } }
}
__device__ __forceinline__ void p11_row_finish(const Frame& F, int m, f32x4 (&v)[4], const unsigned (&y)[4][TOPK], float* outp, int lane) {
    float s = 0.f;
#pragma unroll
    for (int j = 0; j < 4; ++j) {
#pragma unroll
        for (int k = 0; k < TOPK; ++k) {
#if MOE_FP8
            const f32x2 lo = __builtin_amdgcn_cvt_pk_f32_fp8((int)y[j][k], false), hi2 = __builtin_amdgcn_cvt_pk_f32_fp8((int)y[j][k], true); v[j][0] += lo[0] * 0.0625f; v[j][1] += lo[1] * 0.0625f; v[j][2] += hi2[0] * 0.0625f; v[j][3] += hi2[1] * 0.0625f;
#else
            const u32x2 yy = *((const u32x2*)(F.YSLOT + ((size_t)m * 4 + k) * D) + lane + 64 * j); v[j][0] += bflo(yy.x); v[j][1] += bfhi(yy.x); v[j][2] += bflo(yy.y); v[j][3] += bfhi(yy.y);
#endif
        }
        s += (v[j][0] * v[j][0] + v[j][1] * v[j][1]) + (v[j][2] * v[j][2] + v[j][3] * v[j][3]); }
    s = wave_sum(s); const float r = rsqrtf(s * (1.0f / D) + RMS_EPS);
    f32x4* orow = (f32x4*)(outp + (size_t)m * D) + lane;
#pragma unroll
    for (int j = 0; j < 4; ++j) { const f32x4 g = *((const f32x4*)F.norm_final + lane + 64 * j); orow[64 * j] = v[j] * r * g; }
}
__device__ __forceinline__ void p11_final(Frame& F, float* outp) {
    const int gw = F.bid * NWAVES + F.wave, NGW = F.G * NWAVES, lane = F.lane;
    for (int m = gw; m < T; m += 2 * NGW) {
        const int m2 = m + NGW; f32x4 va[4], vb[4]; unsigned ya[4][TOPK], yb[4][TOPK];
        p11_row_load(F, m, va, ya, lane); if (m2 < T) p11_row_load(F, m2, vb, yb, lane);
        p11_row_finish(F, m, va, ya, outp, lane); if (m2 < T) p11_row_finish(F, m2, vb, yb, outp, lane);
    }
}
#ifndef ATTN_EARLY
#define ATTN_EARLY 1
#endif
constexpr float ATTN_THR = 152.0f;
__device__ __forceinline__ bf16x8 pack8(float a0, float a1, float a2, float a3, float a4, float a5, float a6, float a7) {
    return __builtin_bit_cast(bf16x8, (u32x4){cvt_pk_bf16(a0, a1), cvt_pk_bf16(a2, a3), cvt_pk_bf16(a4, a5), cvt_pk_bf16(a6, a7)});
}
template <bool DIAG>
__device__ __forceinline__ void attn_block(const f32x16& sv, float& R, const bf16x8 (&tri)[2], bf16x8 (&wb)[2], int keyb, int tq, int r32, int hi) {
    float sp[16];
#pragma unroll
    for (int i = 0; i < 16; ++i) { const float z = sv[i]; const float l = __builtin_amdgcn_logf(1.0f + __builtin_amdgcn_exp2f(-__builtin_fabsf(z)));
        float v = __builtin_fmaxf(z, 0.f) + l; if (DIAG) v = (keyb + crow(i, hi) < tq) ? v : 0.f; sp[i] = v; }
    const bf16x8 b0 = pack8(sp[0], sp[1], sp[2], sp[3], sp[4], sp[5], sp[6], sp[7]), b1 = pack8(sp[8], sp[9], sp[10], sp[11], sp[12], sp[13], sp[14], sp[15]);
    f32x16 c;
#pragma unroll
    for (int i = 0; i < 16; ++i) c[i] = R;
    c = __builtin_amdgcn_mfma_f32_32x32x16_bf16(tri[0], b0, c, 0, 0, 0);
    c = __builtin_amdgcn_mfma_f32_32x32x16_bf16(tri[1], b1, c, 0, 0, 0);
    float w[16];
#pragma unroll
    for (int i = 0; i < 16; ++i) { float v = __builtin_amdgcn_exp2f(sv[i] - c[i]); if (DIAG) v = (keyb + crow(i, hi) < tq) ? v : 0.f; w[i] = v; }
    wb[0] = pack8(w[0], w[1], w[2], w[3], w[4], w[5], w[6], w[7]); wb[1] = pack8(w[8], w[9], w[10], w[11], w[12], w[13], w[14], w[15]);
    R = __shfl(c[0], r32);
}
__device__ __forceinline__ void attn_load_k(const Frame& F, bf16x8 (&kf)[2][4], int tokbase, int k0, int h, int r32, int hi) {
    const bf16_t* kp = F.KB + (size_t)(tokbase + k0 + r32) * SBW + h * HD + 8 * hi;
#pragma unroll
    for (int mt = 0; mt < 2; ++mt)
#pragma unroll
        for (int d0 = 0; d0 < 4; ++d0) kf[mt][d0] = *(const bf16x8*)(kp + (size_t)mt * 32 * SBW + 16 * d0);
}
__device__ __forceinline__ void attn_unit(Frame& F, int b, int h, int qb, const bf16x8 (&tri)[2]) {
    const int lane = F.lane, r32 = lane & 31, hi = lane >> 5, tokbase = b * SEQ, q0 = qb * 32, tq = q0 + r32;
    const bf16_t* qp = F.QB + (size_t)(tokbase + tq) * SBW + h * HD + 8 * hi;
    bf16x8 qf[4];
#pragma unroll
    for (int d0 = 0; d0 < 4; ++d0) qf[d0] = *(const bf16x8*)(qp + 16 * d0);
    f32x16 o0 = {}, o1 = {}; float R = 0.f;
    bf16x8 kf[2][4], kn[2][4];
    attn_load_k(F, kf, tokbase, (qb >> 1) * 64, h, r32, hi);
    for (int kt = qb >> 1; kt >= 0; --kt) {
        const int k0 = kt * 64;
        const bf16_t* vp = F.VT + (size_t)(h * HD + r32) * T + tokbase + k0 + 4 * hi;
        u32x2 vlo[2][2][2], vhi[2][2][2];
#pragma unroll
        for (int dm = 0; dm < 2; ++dm)
#pragma unroll
            for (int mt = 0; mt < 2; ++mt)
#pragma unroll
                for (int s = 0; s < 2; ++s) { const bf16_t* p = vp + (size_t)dm * 32 * T + 32 * mt + 16 * s; vlo[dm][mt][s] = *(const u32x2*)p; vhi[dm][mt][s] = *(const u32x2*)(p + 8); }
        attn_load_k(F, kn, tokbase, kt > 0 ? k0 - 64 : k0, h, r32, hi);
        f32x16 s0 = {}, s1 = {};
#pragma unroll
        for (int d0 = 0; d0 < 4; ++d0) { s0 = __builtin_amdgcn_mfma_f32_32x32x16_bf16(kf[0][d0], qf[d0], s0, 0, 0, 0); s1 = __builtin_amdgcn_mfma_f32_32x32x16_bf16(kf[1][d0], qf[d0], s1, 0, 0, 0); }
        bf16x8 wb[2][2];
        if (kt == (qb >> 1)) { attn_block<true>(s1, R, tri, wb[1], k0 + 32, tq, r32, hi); attn_block<true>(s0, R, tri, wb[0], k0, tq, r32, hi); }
        else { attn_block<false>(s1, R, tri, wb[1], k0 + 32, tq, r32, hi); attn_block<false>(s0, R, tri, wb[0], k0, tq, r32, hi); }
#pragma unroll
        for (int mt = 0; mt < 2; ++mt)
#pragma unroll
            for (int s = 0; s < 2; ++s) { const bf16x8 v0 = __builtin_bit_cast(bf16x8, (u32x4){vlo[0][mt][s].x, vlo[0][mt][s].y, vhi[0][mt][s].x, vhi[0][mt][s].y}), v1 = __builtin_bit_cast(bf16x8, (u32x4){vlo[1][mt][s].x, vlo[1][mt][s].y, vhi[1][mt][s].x, vhi[1][mt][s].y});
                o0 = __builtin_amdgcn_mfma_f32_32x32x16_bf16(v0, wb[mt][s], o0, 0, 0, 0); o1 = __builtin_amdgcn_mfma_f32_32x32x16_bf16(v1, wb[mt][s], o1, 0, 0, 0); }
        if (ATTN_EARLY) { if (__all(R > ATTN_THR)) break; }
#pragma unroll
        for (int mt = 0; mt < 2; ++mt)
#pragma unroll
            for (int d0 = 0; d0 < 4; ++d0) kf[mt][d0] = kn[mt][d0];
    }
    bf16_t* op = F.YSB + (size_t)(tokbase + tq) * SBW + h * HD + 4 * hi;
#pragma unroll
    for (int g = 0; g < 4; ++g) { u32x2 a, c2; a.x = cvt_pk_bf16(o0[4 * g], o0[4 * g + 1]); a.y = cvt_pk_bf16(o0[4 * g + 2], o0[4 * g + 3]); c2.x = cvt_pk_bf16(o1[4 * g], o1[4 * g + 1]); c2.y = cvt_pk_bf16(o1[4 * g + 2], o1[4 * g + 3]);
        *(u32x2*)(op + 8 * g) = a; *(u32x2*)(op + 32 + 8 * g) = c2; }
}
__device__ __forceinline__ void attn_phase(Frame& F) {
    const int lane = F.lane, r32 = lane & 31, hi = lane >> 5;
    bf16x8 tri[2];
#pragma unroll
    for (int s = 0; s < 2; ++s)
#pragma unroll
        for (int j = 0; j < 8; ++j) tri[s][j] = (16 * s + 8 * (j >> 2) + 4 * hi + (j & 3) >= r32) ? (short)0x3F80 : (short)0;
    constexpr int NU = NB * NH * 128;
    if (F.G == 256) {
        if (F.bid < 128) { const int u = 3072 + F.bid * 8 + F.wave; attn_unit(F, u >> 10, (u >> 7) & 7, u & 127, tri); }
        else for (int r = 0; r < 3; ++r) { const int u = r * 1024 + (F.bid - 128) * 8 + F.wave; attn_unit(F, u >> 10, (u >> 7) & 7, u & 127, tri); }
    } else for (int u = F.bid * NWAVES + F.wave; u < NU; u += F.G * NWAVES) attn_unit(F, u >> 10, (u >> 7) & 7, u & 127, tri);
}
struct Args { const float* in[23]; float* out; unsigned char* ws; int ph_lo, ph_hi, li, pad; };
constexpr int N_PHASES = 12;
__global__ void __launch_bounds__(NWAVES * 64, 2) mk(Args args) {
    extern __shared__ __attribute__((aligned(16))) unsigned char lds[];
    Frame F;
    F.lds = (LAS unsigned char*)lds; F.MISC = (volatile LAS unsigned*)(F.lds + MISC_OFF);
    F.tid = threadIdx.x; F.lane = F.tid & 63; F.wave = __builtin_amdgcn_readfirstlane(F.tid >> 6); F.G = gridDim.x; F.bid = blockIdx.x;
    unsigned char* ws = args.ws; F.ws = ws; F.out = args.out; F.ctl = (unsigned*)(ws + WS_CTL);
    F.x = args.in[0]; F.norm_mix = args.in[1]; F.w_in = args.in[2]; F.lam_re = args.in[3]; F.lam_im = args.in[4]; F.b_re = args.in[5]; F.b_im = args.in[6]; F.c_re = args.in[7]; F.c_im = args.in[8];
    F.s5d = args.in[9]; F.log_step = args.in[10]; F.w_glu = args.in[11]; F.w_bsb = args.in[12]; F.w_bs5 = args.in[13]; F.w_out = args.in[14]; F.norm_ffn = args.in[15]; F.w_router = args.in[16];
    F.b_router = args.in[17]; F.w_up = args.in[18]; F.b_up = args.in[19]; F.w_down = args.in[20]; F.b_down = args.in[21]; F.norm_final = args.in[22];
    F.RSTD1 = (float*)(ws + WS_RSTD1); F.RSTD2 = (float*)(ws + WS_RSTD2); F.RB = (int*)(ws + WS_RB); F.LIST = (int*)(ws + WS_LIST); F.GATEL = (float*)(ws + WS_GATEL); F.SS2P = (float*)(ws + WS_SS2P);
    F.WR = (bf16_t*)(ws + WS_WR); F.XB = (bf16_t*)(ws + WS_XB); F.QB = (bf16_t*)(ws + WS_QB); F.KB = (bf16_t*)(ws + WS_KB); F.VT = (bf16_t*)(ws + WS_VT); F.UB = (bf16_t*)(ws + WS_UB);
    F.GSB = (bf16_t*)(ws + WS_GSB); F.GS5 = (bf16_t*)(ws + WS_GS5); F.YSB = (bf16_t*)(ws + WS_YSB); F.Y2 = (bf16_t*)(ws + WS_Y2); F.YS5 = (bf16_t*)(ws + WS_YS5); F.MRG = (bf16_t*)(ws + WS_MRG);
    F.X1B = (bf16_t*)(ws + WS_X1B); F.X1BF = (bf16_t*)(ws + WS_X1BF); F.ACT = (bf16_t*)(ws + WS_ACT); F.YSLOT = (bf16_t*)(ws + WS_YSLOT); F.WIN = (bf16_t*)(ws + WS_WIN); F.WGLU = (bf16_t*)(ws + WS_WGLU); F.WBSB = (bf16_t*)(ws + WS_WBSB);
    F.WBS5 = (bf16_t*)(ws + WS_WBS5); F.WOUT = (bf16_t*)(ws + WS_WOUT); F.M1T = (bf16_t*)(ws + WS_M1T); F.YT = (bf16_t*)(ws + WS_YT); F.SLOC = (float*)(ws + WS_SLOC); F.SIN = (bf16_t*)(ws + WS_SIN);
    F.WUP = (bf16_t*)(ws + WS_WUP); F.WDN = (bf16_t*)(ws + WS_WDN);
    for (int u = F.tid; u < (LDS_BYTES - RING_BYTES) / 4; u += NWAVES * 64) ((LAS unsigned*)(F.lds + RING_BYTES))[u] = 0u;
    __syncthreads();
    const int lo = args.ph_lo, hi = args.ph_hi;
    XcdBarrier bar; bar.bar = (unsigned*)(F.ctl + CW_BAR) + args.li * XCD_BAR_WORDS; bar.x = 0; bar.st = nullptr;
    if (hi - lo > 1) bar = xcd_barrier_post((unsigned*)(F.ctl + CW_BAR) + args.li * XCD_BAR_WORDS, F.MISC + 8);
#define IN(k) (lo <= (k) && (k) < hi)
#define NEXT_PH(k) ((k) == 2 ? 5 : (k) + 1)
#define BOTH(k) (IN(k) && IN(NEXT_PH(k)))
    if (IN(0)) { p0_prologue(F); __syncthreads(); cvt_expert_items(F); if (BOTH(0)) xcd_barrier(bar); }
    if (IN(1)) {
        pg::SrcPlain G{D}; SchedP1 S{F.G, F.bid, (const char*)F.XB, (const char*)F.WIN, 0, 1 << 20}; EpiInProj E{F.RSTD1, F.QB, F.KB, F.UB, F.GSB, F.GS5, F.VT};
        pg::gemm_phase(F.lds, G, S, E);
        if (BOTH(1)) xcd_barrier(bar);
    }
    if (IN(2)) {
        const bool fuse_glu = (F.G == 256);
        if (F.bid < NB * S5G) {
            { pg::SrcS5 G{4, 0, 256}; SchedS5 S{F.G, F.bid, (const char*)F.UB, (const char*)F.SIN, (const char*)F.M1T, (size_t)256 * 256 * 2}; EpiSloc E{F.SLOC}; pg::gemm_phase(F.lds, G, S, E); }
            p3_scan(F);
            { pg::SrcS5 G{4, 2, 384}; SchedS5 S{F.G, F.bid, (const char*)F.UB, (const char*)F.SIN, (const char*)F.YT, (size_t)256 * 384 * 2}; EpiY E{F.Y2}; pg::gemm_phase(F.lds, G, S, E); }
            if (fuse_glu) xcd_barrier(bar);
            attn_phase(F);
        } else {
            attn_phase(F);
            if (fuse_glu) {
                xcd_barrier(bar);
                const int gu = F.bid - 128, gpm = gu >> 1;
                pg::SrcPlain G{S5W}; SchedOne S{gpm, gu & 1, (const char*)F.Y2 + (size_t)gpm * 256 * S5W * 2, (const char*)F.WGLU + (size_t)(gu & 1) * 256 * S5W * 2}; EpiGlu E{F.Y2, F.YS5};
                pg::gemm_phase(F.lds, G, S, E);
            }
        }
        if (BOTH(2)) xcd_barrier(bar);
    }
    if (IN(5) && F.G != 256) {
        pg::SrcPlain G{S5W}; SchedTiles S{F.G, F.bid, T / 256, S5W / 256, 1, (const char*)F.Y2, nullptr, (const char*)F.WGLU, nullptr, (size_t)256 * S5W * 2, (size_t)256 * S5W * 2}; EpiGlu E{F.Y2, F.YS5};
        pg::gemm_phase(F.lds, G, S, E);
        if (BOTH(5)) xcd_barrier(bar);
    }
    if (IN(6)) {
        pg::SrcPlain G{SBW}; SchedTiles S{F.G, F.bid, T / 256, D / 256, 2, (const char*)F.YSB, (const char*)F.YS5, (const char*)F.WBSB, (const char*)F.WBS5, (size_t)256 * SBW * 2, (size_t)256 * SBW * 2}; EpiMerge E{F.GSB, F.GS5, F.MRG};
        pg::gemm_phase(F.lds, G, S, E);
        if (BOTH(6)) xcd_barrier(bar);
    }
    if (IN(7)) {
        pg::SrcPlain G{D}; SchedTiles S{F.G, F.bid, T / 256, D / 256, 1, (const char*)F.MRG, nullptr, (const char*)F.WOUT, nullptr, (size_t)256 * D * 2, (size_t)256 * D * 2}; EpiOut E{F.XB, F.X1BF, F.X1B, F.SS2P, F.norm_ffn};
        pg::gemm_phase(F.lds, G, S, E);
        if (BOTH(7)) xcd_barrier(bar);
    }
    if (IN(8)) { p8_router(F, F.ctl + CW_CNT, F.LIST, F.GATEL, (float*)(F.ws + WS_RS2L)); if (BOTH(8)) xcd_barrier(bar); }
#if MOE_FP8
#define MOE_UP(S_)   do { pg::SrcGather8 G{D, 6}; EpiUpM E{F.b_up, F.ACT}; pg::gemm_phase_f8m(F.lds, F.lds + META_OFF, G, S_, E); } while (0)
#define MOE_DOWN(S_) do { pg::SrcPlain8 G{DFF, 6}; EpiDownM E{F.b_down, F.YSLOT}; pg::gemm_phase_f8m(F.lds, F.lds + META_OFF, G, S_, E); } while (0)
#define SCHED_UP(off, hi, one)   SchedMoe{off, hi, one, F.G, F.bid, 8, 0, 0, F.LIST, (const float*)(F.ws + WS_RS2L), (const char*)F.X1B, (const char*)F.WUP, (size_t)2 * DFF * D, 0, (size_t)256 * D, true, F.b_up}
#define SCHED_DOWN(off, hi, one) SchedMoe{off, hi, one, F.G, F.bid, 4, 0, 0, F.LIST, F.GATEL, (const char*)F.ACT, (const char*)F.WDN, (size_t)D * DFF, (size_t)256 * DFF, (size_t)256 * DFF, false, F.b_down}
#else
#define MOE_UP(S_)   do { pg::SrcGather G{D}; EpiUp E{(const float*)(F.ws + WS_RS2L), F.b_up, F.ACT}; pg::gemm_phase(F.lds, G, S_, E); } while (0)
#define MOE_DOWN(S_) do { pg::SrcPlain G{DFF}; EpiDown E{F.GATEL, F.b_down, F.YSLOT}; pg::gemm_phase(F.lds, G, S_, E); } while (0)
#define SCHED_UP(off, hi, one)   SchedMoe{off, hi, one, F.G, F.bid, 8, 0, 0, F.LIST, F.GATEL, (const char*)F.X1B, (const char*)F.WUP, (size_t)2 * DFF * D * 2, 0, (size_t)256 * D * 2, true, F.b_up}
#define SCHED_DOWN(off, hi, one) SchedMoe{off, hi, one, F.G, F.bid, 4, 0, 0, F.LIST, F.GATEL, (const char*)F.ACT, (const char*)F.WDN, (size_t)D * DFF * 2, (size_t)256 * DFF * 2, (size_t)256 * DFF * 2, false, F.b_down}
#endif
    if (IN(9)) {
        moe_prefix(F);
        const LAS unsigned* tab = (const LAS unsigned*)(F.lds + MISC_OFF) + 16;
        const bool split = (F.G == 256);
        SchedMoe S0 = SCHED_UP(0, 0, 0); S0.load_tables(tab, F.lane);
        const int RT = S0.total_rt(), FR = RT / 32, nupx = (RT - FR * 32 + 3) / 4;
        { SchedMoe S = SCHED_UP(0, split ? FR * 32 : RT, 0); S.tpre = S0.tpre; S.tcnt = S0.tcnt; MOE_UP(S); }
        if (split) {
            xcd_barrier(bar);
            const int x = F.bid & 7;
            if (x < nupx) { SchedMoe S = SCHED_UP(8 * FR, RT, 1); S.tpre = S0.tpre; S.tcnt = S0.tcnt; MOE_UP(S); }
            else { SchedMoe S = SCHED_DOWN(-nupx, FR * 32, 1); S.tpre = S0.tpre; S.tcnt = S0.tcnt; MOE_DOWN(S); }
        }
        if (BOTH(9)) xcd_barrier(bar);
    }
    if (IN(10)) {
        if (!IN(9)) moe_prefix(F);
        const LAS unsigned* tab = (const LAS unsigned*)(F.lds + MISC_OFF) + 16;
        SchedMoe S = SCHED_DOWN(0, 0, 0); S.load_tables(tab, F.lane);
        const int RT = S.total_rt(), FR = RT / 32, nupx = (RT - FR * 32 + 3) / 4;
        S.rt_hi = RT; S.sb_off = (F.G == 256 && IN(9)) ? 8 - nupx : 0;
        MOE_DOWN(S);
        if (BOTH(10)) xcd_barrier(bar);
    }
    if (IN(11)) p11_final(F, F.out);
#undef IN
#undef BOTH
}

static void launch_mk(Args& a, int lo, int hi, int li, int grid, hipStream_t stream) {
    a.ph_lo = lo; a.ph_hi = hi; a.li = li;
    hipLaunchKernelGGL(mk, dim3(grid), dim3(NWAVES * 64), LDS_BYTES, stream, a);
}
extern "C" void kernel_launch(void* const* d_in, const int* in_sizes, int n_in, void* d_out, int out_size, void* d_ws, size_t ws_size, hipStream_t stream) {
    static int grid = 0;
    if (grid == 0) {
        if (n_in != 23 || ws_size < WS_END3 || out_size != T * D) { fprintf(stderr, "kernel_launch: unexpected n_in %d / out %d / ws %zu\n", n_in, out_size, ws_size); grid = -1; return; }
        int dev = 0, cus = 0;
        if (hipGetDevice(&dev) != hipSuccess || hipDeviceGetAttribute(&cus, hipDeviceAttributeMultiprocessorCount, dev) != hipSuccess) { grid = -1; return; }
        if (hipFuncSetAttribute((const void*)mk, hipFuncAttributeMaxDynamicSharedMemorySize, LDS_BYTES) != hipSuccess) { fprintf(stderr, "kernel_launch: hipFuncSetAttribute failed\n"); grid = -1; return; }
        int per_cu = 0; (void)hipOccupancyMaxActiveBlocksPerMultiprocessor(&per_cu, (const void*)mk, NWAVES * 64, LDS_BYTES); (void)hipGetLastError();
        if (per_cu < 1) fprintf(stderr, "kernel_launch: occupancy query says %d blocks per CU\n", per_cu);
        grid = cus;
    }
    if (grid < 0) return;
    const float* x = (const float*)d_in[0];
    const float* w_glu = (const float*)d_in[11]; const float* w_bsb = (const float*)d_in[12]; const float* w_bs5 = (const float*)d_in[13]; const float* w_out = (const float*)d_in[14];
    const float* norm_ffn = (const float*)d_in[15]; const float* w_router = (const float*)d_in[16]; const float* b_router = (const float*)d_in[17];
    const float* w_up = (const float*)d_in[18]; const float* b_up = (const float*)d_in[19]; const float* w_down = (const float*)d_in[20]; const float* b_down = (const float*)d_in[21];
    const float* norm_final = (const float*)d_in[22];
    unsigned char* ws = (unsigned char*)d_ws; float* out = (float*)d_out;
    unsigned* ctl = (unsigned*)(ws + WS_CTL); float* RSTD2 = (float*)(ws + WS_RSTD2); int* RB = (int*)(ws + WS_RB);
    int* LIST = (int*)(ws + WS_LIST); float* GATEL = (float*)(ws + WS_GATEL);
    bf16_t *QB = (bf16_t*)(ws + WS_QB), *KB = (bf16_t*)(ws + WS_KB), *VT = (bf16_t*)(ws + WS_VT), *UB = (bf16_t*)(ws + WS_UB), *GSB = (bf16_t*)(ws + WS_GSB), *GS5 = (bf16_t*)(ws + WS_GS5);
    bf16_t *YSB = (bf16_t*)(ws + WS_YSB), *Y2 = (bf16_t*)(ws + WS_Y2), *YS5 = (bf16_t*)(ws + WS_YS5), *MRG = (bf16_t*)(ws + WS_MRG), *X1B = (bf16_t*)(ws + WS_X1B), *ACT = (bf16_t*)(ws + WS_ACT), *YSLOT = (bf16_t*)(ws + WS_YSLOT);
    float* TA = (float*)(ws + WS_TMPA); float* TA2 = TA + (size_t)T * D;
    float* TM = (float*)(ws + WS_TMPM); float* TM2 = TM + (size_t)T * 2 * DFF;
    (void)hipMemsetAsync(ws + WS_CTL, 0, CTL_BYTES, stream);
    Args a{}; for (int i = 0; i < 23; ++i) a.in[i] = (const float*)d_in[i]; a.out = out; a.ws = ws;
    launch_mk(a, 0, N_PHASES, 0, grid, stream);
}
```

```cpp
#include <hip/hip_runtime.h>
#include <cstdio>
#include <cstdint>

typedef unsigned short bf16_t;
#define LAS __attribute__((address_space(3)))
#define GAS __attribute__((address_space(1)))
typedef short bf16x8 __attribute__((ext_vector_type(8)));
typedef float f32x4 __attribute__((ext_vector_type(4)));
typedef float f32x2 __attribute__((ext_vector_type(2)));
typedef float f32x16 __attribute__((ext_vector_type(16)));
typedef unsigned u32x4 __attribute__((ext_vector_type(4)));
typedef unsigned u32x2 __attribute__((ext_vector_type(2)));

#ifndef MOE_FP8
#define MOE_FP8 1
#endif
constexpr int NB = 4, SEQ = 4096, D = 1024, T = NB * SEQ;
constexpr int NH = 8, HD = 64, SBW = 512, S5W = 512, S5G = 32, S5H = 16, S5P = 64;
constexpr int NE = 32, TOPK = 4, DFF = 1024, INW = 4096;
constexpr int OFF_K = 512, OFF_V = 1024, OFF_U = 1536, OFF_GA = 2048, OFF_GB = 3072;
constexpr float RMS_EPS = 1e-5f, LIMIT = 7.0f, ALPHA = 1.702f;
constexpr float LOG2E = 1.4426950408889634f, LN2 = 0.6931471805599453f;
constexpr float C2 = 0.125f * LOG2E;
constexpr int LC = 16, NCHUNK = T / LC;
constexpr int ACT_ROWS = T * TOPK + NE * 256;

constexpr size_t MiB = 1u << 20;
constexpr size_t WS_CTL = 0, CTL_BYTES = 64 * 1024;
constexpr size_t WS_RSTD1 = 1 * MiB, WS_RSTD2 = 1 * MiB + 65536, WS_RB = 1 * MiB + 131072;
constexpr size_t WS_RS2L = 799 * MiB  , WS_END2 = 801 * MiB;
constexpr size_t WS_X1BF = 802 * MiB  , WS_END3 = 834 * MiB;
constexpr size_t WS_LIST = 2 * MiB, WS_GATEL = 4 * MiB, WS_SS2P = 6 * MiB  , WS_WR = 7 * MiB  ;
constexpr size_t WS_XB = 8 * MiB, WS_QB = 40 * MiB, WS_KB = 56 * MiB, WS_VT = 72 * MiB, WS_UB = 88 * MiB;
constexpr size_t WS_GSB = 104 * MiB, WS_GS5 = 136 * MiB, WS_YSB = 168 * MiB, WS_Y2 = 184 * MiB, WS_YS5 = 200 * MiB;
constexpr size_t WS_MRG = 216 * MiB, WS_X1B = 248 * MiB, WS_ACT = 280 * MiB, WS_YSLOT = 424 * MiB;
constexpr size_t WS_WIN = 552 * MiB  , WS_WGLU = 560 * MiB, WS_WBSB = 561 * MiB, WS_WBS5 = 562 * MiB, WS_WOUT = 563 * MiB;
constexpr size_t WS_M1T = 565 * MiB  , WS_YT = 569 * MiB  ;
constexpr size_t WS_SLOC = 575 * MiB  , WS_SIN = 591 * MiB  ;
constexpr size_t WS_WUP = 607 * MiB  , WS_WDN = 735 * MiB  , WS_END = 799 * MiB;
constexpr size_t WS_TMPA = 280 * MiB;
constexpr size_t WS_TMPM = 8 * MiB;
constexpr int CW_TMO = 0, CW_QATT = 256  , CW_QCVT = 320  , CW_YDONE = 384  , CW_CNT = 1024  , CW_BAR = 4096  ;

__device__ __forceinline__ float bf2f(bf16_t v) { return __uint_as_float(((unsigned)v) << 16); }
__device__ __forceinline__ bf16_t f2bf(float f) { unsigned u = __float_as_uint(f); u += 0x7fffu + ((u >> 16) & 1u); return (bf16_t)(u >> 16); }
__device__ __forceinline__ float ldf(const float* p) { return *p; }
__device__ __forceinline__ float ldf(const bf16_t* p) { return bf2f(*p); }
__device__ __forceinline__ float bflo(unsigned w) { return __uint_as_float(w << 16); }
__device__ __forceinline__ float bfhi(unsigned w) { return __uint_as_float(w & 0xffff0000u); }
typedef __bf16 bf16x2_t __attribute__((ext_vector_type(2)));
__device__ __forceinline__ unsigned cvt_pk_bf16(float lo, float hi) { const f32x2 v = {lo, hi}; const bf16x2_t b = __builtin_convertvector(v, bf16x2_t); return __builtin_bit_cast(unsigned, b); }
__device__ __forceinline__ float sigmoidf_(float x) { return 1.0f / (1.0f + expf(-x)); }
__device__ __forceinline__ float fast_sigmoid(float x) { return __builtin_amdgcn_rcpf(1.0f + __builtin_amdgcn_exp2f(-LOG2E * x)); }
__device__ __forceinline__ float wave_sum(float v) {
#pragma unroll
    for (int o = 1; o < 64; o <<= 1) v += __shfl_xor(v, o);
    return v;
}
__device__ __forceinline__ float gelu_tanh(float x) {
    constexpr float C1 = -2.0f * LOG2E * 0.7978845608028654f, C2 = C1 * 0.044715f;
    return x * __builtin_amdgcn_rcpf(1.0f + __builtin_amdgcn_exp2f(x * __builtin_fmaf(C2, x * x, C1)));
}
namespace pg {
constexpr int BM = 256, BK = 64, HALF = 128, HTB = HALF * BK * 2  , STAGE_BYTES = 8 * HTB;
__device__ __forceinline__ int lds_byte(int r, int c) { const int st = (r >> 4) * 2 + (c >> 5), rr = r & 15, cc = c & 31, ob = rr * 64 + cc * 2; return st * 1024 + (ob ^ (((ob >> 9) & 1) << 5)); }
__device__ __forceinline__ void stage_rc(int b, int& R, int& C) { const int st = b / 1024, sb = b % 1024, swz = sb ^ (((sb >> 9) & 1) << 5); R = (st >> 1) * 16 + swz / 64; C = (st & 1) * 32 + (swz % 64) / 2; }
__device__ __forceinline__ int perm32(int rho) { const int n = rho >> 4, i = rho & 15; return 8 * (i >> 2) + 4 * n + (i & 3); }

struct GUnit { const char* A; const char* A2; const char* B; const int* list; const float* bias; int pm, pn, x0, x1, nvalid, bstep; };

template <class Src, class Epi, class Sched>
__device__ __forceinline__ void gemm_phase(LAS unsigned char* lds, const Src& G, const Sched& S, const Epi& E) {
    const int tid = threadIdx.x, wid = __builtin_amdgcn_readfirstlane(tid >> 6), lane = tid & 63, wr = wid >> 2, wc = wid & 3, fr = lane & 15, fq = lane >> 4;
    const int nt = G.nt();
    int sR[2], sC[2];
#pragma unroll
    for (int i = 0; i < 2; ++i) stage_rc(tid * 16 + i * 8192, sR[i], sC[i]);
    unsigned voffB[2];
#pragma unroll
    for (int i = 0; i < 2; ++i) { const int Rb = Epi::PERM ? ((sR[i] & ~31) + perm32(sR[i] & 31)) : sR[i]; voffB[i] = G.b_off(Rb, sC[i]); }
    const size_t bh = G.b_hstep();
    const unsigned ldsw = (unsigned)wid * 1024u;
    const int aoff = lds_byte(wr * 64 + fr, fq * 8), boff = lds_byte(wc * 32 + fr, fq * 8);
#define PG_SA(b, h) (((b) * 2 + (h)) * HTB)
#define PG_SB(b, h) ((4 + (b) * 2 + (h)) * HTB)
#define PG_STAGE2(bufoff, gbase, o0, o1) do { \
        __builtin_amdgcn_global_load_lds((const unsigned*)((const char*)(gbase) + (o0)), (LAS unsigned*)(lds + (bufoff) + ldsw), 16, 0, 0); \
        __builtin_amdgcn_global_load_lds((const unsigned*)((const char*)(gbase) + (o1)), (LAS unsigned*)(lds + (bufoff) + ldsw + 8192), 16, 0, 0); } while (0)
#define PG_STAGE(bufoff, gbase, voff) PG_STAGE2(bufoff, gbase, (voff)[0], (voff)[1])
#define PG_LDA(dst, b, h) do { _Pragma("unroll") for (int m = 0; m < 4; ++m) _Pragma("unroll") for (int k = 0; k < 2; ++k) dst[m][k] = *(const LAS bf16x8*)(lds + PG_SA(b, h) + aoff + m * 2048 + k * 1024); } while (0)
#define PG_LDB(dst, b, h) do { _Pragma("unroll") for (int n = 0; n < 2; ++n) _Pragma("unroll") for (int k = 0; k < 2; ++k) dst[n][k] = *(const LAS bf16x8*)(lds + PG_SB(b, h) + boff + n * 2048 + k * 1024); } while (0)
#define PG_MMA(ai, bj, At, Bt) do { __builtin_amdgcn_s_setprio(1); _Pragma("unroll") for (int m = 0; m < 4; ++m) _Pragma("unroll") for (int n = 0; n < 2; ++n) _Pragma("unroll") for (int k = 0; k < 2; ++k) \
        acc[ai][bj][m][n] = __builtin_amdgcn_mfma_f32_16x16x32_bf16(Bt[n][k], At[m][k], acc[ai][bj][m][n], 0, 0, 0); __builtin_amdgcn_s_setprio(0); } while (0)
#define PG_WAIT_V(n) asm volatile("s_waitcnt vmcnt(" #n ")" ::: "memory")
#define PG_WAIT_L(n) asm volatile("s_waitcnt lgkmcnt(" #n ")" ::: "memory")
#define PG_BAR __builtin_amdgcn_s_barrier()
#define PG_SCHED __builtin_amdgcn_sched_barrier(0)
    GUnit cur, nxt; int ui = 0;
    if (!S.next(0, cur)) return;
    unsigned vA00 = G.a_off(cur, sR[0], sC[0]), vA01 = G.a_off(cur, sR[1], sC[1]), vA10 = G.a_off(cur, sR[0] + HALF, sC[0]), vA11 = G.a_off(cur, sR[1] + HALF, sC[1]);
    unsigned vN00 = vA00, vN01 = vA01, vN10 = vA10, vN11 = vA11;
    f32x4 acc[2][2][4][2];
#pragma unroll
    for (int a = 0; a < 2; ++a)
#pragma unroll
        for (int b = 0; b < 2; ++b)
#pragma unroll
            for (int m = 0; m < 4; ++m)
#pragma unroll
                for (int n = 0; n < 2; ++n) acc[a][b][m][n] = (f32x4){0.f, 0.f, 0.f, 0.f};
    bf16x8 At[4][2], B0[2][2], B1[2][2];
    { const char* a0 = G.a_tile(cur, 0); const char* b0 = G.b_tile(cur, 0); const char* a1 = G.a_tile(cur, 1); const char* b1 = G.b_tile(cur, 1);
      PG_STAGE(PG_SB(0, 0), b0, voffB); PG_STAGE(PG_SB(0, 1), b0 + bh, voffB); PG_STAGE2(PG_SA(0, 0), a0, vA00, vA01); PG_STAGE2(PG_SA(0, 1), a0, vA10, vA11);
      if (wr == 1) PG_BAR;
      PG_WAIT_V(2); PG_BAR;
      PG_STAGE(PG_SB(1, 0), b1, voffB); PG_STAGE2(PG_SA(1, 0), a1, vA00, vA01); PG_STAGE(PG_SB(1, 1), b1 + bh, voffB);
      PG_WAIT_V(6); PG_BAR; }
    for (;;) {
        const bool has_next = S.next(ui + 1, nxt);
        if constexpr (Src::A_PER_UNIT) {
            if (has_next) { vN00 = G.a_off(nxt, sR[0], sC[0]); vN01 = G.a_off(nxt, sR[1], sC[1]); vN10 = G.a_off(nxt, sR[0] + HALF, sC[0]); vN11 = G.a_off(nxt, sR[1] + HALF, sC[1]); }
        }
        const char* nA0 = has_next ? G.a_tile(nxt, 0) : G.a_tile(cur, 0); const char* nA1 = has_next ? G.a_tile(nxt, 1) : G.a_tile(cur, 1);
        const char* nB0 = has_next ? G.b_tile(nxt, 0) : G.b_tile(cur, 0); const char* nB1 = has_next ? G.b_tile(nxt, 1) : G.b_tile(cur, 1);
        for (int t = 0; t < nt; t += 2) {
            const bool last = (t == nt - 2);
            const char* a1 = G.a_tile(cur, t + 1);
            const char* a2 = last ? nA0 : G.a_tile(cur, t + 2); const char* b2 = last ? nB0 : G.b_tile(cur, t + 2);
            const char* a3 = last ? nA1 : G.a_tile(cur, t + 3); const char* b3 = last ? nB1 : G.b_tile(cur, t + 3);
            PG_LDB(B0, 0, 0); PG_LDB(B1, 0, 1); PG_SCHED; PG_LDA(At, 0, 0); PG_STAGE2(PG_SA(1, 1), a1, vA10, vA11);
            if constexpr (Src::A_PER_UNIT) { vA00 = last ? vN00 : vA00; vA01 = last ? vN01 : vA01; vA10 = last ? vN10 : vA10; vA11 = last ? vN11 : vA11; }
            PG_WAIT_V(8); PG_WAIT_L(0); PG_BAR; PG_MMA(0, 0, At, B0); PG_MMA(0, 1, At, B1); PG_BAR; PG_SCHED;
            PG_LDA(At, 0, 1); PG_STAGE(PG_SB(0, 0), b2, voffB); PG_STAGE(PG_SB(0, 1), b2 + bh, voffB); PG_STAGE2(PG_SA(0, 0), a2, vA00, vA01);
            PG_WAIT_V(8); PG_WAIT_L(0); PG_BAR; PG_MMA(1, 0, At, B0); PG_MMA(1, 1, At, B1); PG_BAR; PG_SCHED;
            PG_LDB(B0, 1, 0); PG_LDB(B1, 1, 1); PG_SCHED; PG_LDA(At, 1, 0); PG_STAGE2(PG_SA(0, 1), a2, vA10, vA11);
            PG_WAIT_V(8); PG_WAIT_L(0); PG_BAR; PG_MMA(0, 0, At, B0); PG_MMA(0, 1, At, B1); PG_BAR; PG_SCHED;
            PG_LDA(At, 1, 1); PG_STAGE(PG_SB(1, 0), b3, voffB); PG_STAGE(PG_SB(1, 1), b3 + bh, voffB); PG_STAGE2(PG_SA(1, 0), a3, vA00, vA01);
            PG_WAIT_V(8); PG_WAIT_L(0); PG_BAR; PG_MMA(1, 0, At, B0); PG_MMA(1, 1, At, B1); PG_BAR; PG_SCHED;
        }
        if (wr == 0) PG_BAR;
        E(acc, cur, wr, wc, fr, fq);
        if (!has_next) break;
#pragma unroll
        for (int a = 0; a < 2; ++a)
#pragma unroll
            for (int b = 0; b < 2; ++b)
#pragma unroll
                for (int m = 0; m < 4; ++m)
#pragma unroll
                    for (int n = 0; n < 2; ++n) acc[a][b][m][n] = (f32x4){0.f, 0.f, 0.f, 0.f};
        cur = nxt; ++ui;
        if (wr == 1) PG_BAR;
    }
    PG_WAIT_V(0);
    PG_BAR;
#undef PG_SA
#undef PG_SB
#undef PG_STAGE
#undef PG_STAGE2
#undef PG_LDA
#undef PG_LDB
#undef PG_MMA
#undef PG_WAIT_V
#undef PG_WAIT_L
#undef PG_BAR
#undef PG_SCHED
}

typedef int i32x8 __attribute__((ext_vector_type(8)));
template <class Src, class Epi, class Sched>
__device__ __forceinline__ void gemm_phase_f8(LAS unsigned char* lds, const Src& G, const Sched& S, const Epi& E) {
    const int tid = threadIdx.x, wid = __builtin_amdgcn_readfirstlane(tid >> 6), lane = tid & 63, wr = wid >> 2, wc = wid & 3, fr = lane & 15, fq = lane >> 4;
    const int nt = G.nt();
    int sR[2], sC[2];
#pragma unroll
    for (int i = 0; i < 2; ++i) stage_rc(tid * 16 + i * 8192, sR[i], sC[i]);
    unsigned voffB[2];
#pragma unroll
    for (int i = 0; i < 2; ++i) { const int Rb = Epi::PERM ? ((sR[i] & ~31) + perm32(sR[i] & 31)) : sR[i]; voffB[i] = G.b_off(Rb, sC[i]); }
    const size_t bh = G.b_hstep();
    const unsigned ldsw = (unsigned)wid * 1024u;
    const int aoff0 = lds_byte(wr * 64 + fr, fq * 16), boff0 = lds_byte(wc * 32 + fr, fq * 16);
    const int aoffF = aoff0 + ((fq & 1) << 4), aoffS = aoff0 + (((fq & 1) ^ 1) << 4), boffF = boff0 + ((fq & 1) << 4), boffS = boff0 + (((fq & 1) ^ 1) << 4);
    const int scl = G.scale_ab();
#define PG_SA(b, h) (((b) * 2 + (h)) * HTB)
#define PG_SB(b, h) ((4 + (b) * 2 + (h)) * HTB)
#define PG_STAGE2(bufoff, gbase, o0, o1) do { \
        __builtin_amdgcn_global_load_lds((const unsigned*)((const char*)(gbase) + (o0)), (LAS unsigned*)(lds + (bufoff) + ldsw), 16, 0, 0); \
        __builtin_amdgcn_global_load_lds((const unsigned*)((const char*)(gbase) + (o1)), (LAS unsigned*)(lds + (bufoff) + ldsw + 8192), 16, 0, 0); } while (0)
#define PG_STAGE(bufoff, gbase, voff) PG_STAGE2(bufoff, gbase, (voff)[0], (voff)[1])
#define PG_LDA(dst, b, h) do { _Pragma("unroll") for (int m = 0; m < 4; ++m) { const u32x4 _l = *(const LAS u32x4*)(lds + PG_SA(b, h) + aoffF + m * 2048), _h = *(const LAS u32x4*)(lds + PG_SA(b, h) + aoffS + m * 2048); \
        dst[m] = (i32x8){(int)_l.x, (int)_l.y, (int)_l.z, (int)_l.w, (int)_h.x, (int)_h.y, (int)_h.z, (int)_h.w}; } } while (0)
#define PG_LDB(dst, b, h) do { _Pragma("unroll") for (int n = 0; n < 2; ++n) { const u32x4 _l = *(const LAS u32x4*)(lds + PG_SB(b, h) + boffF + n * 2048), _h = *(const LAS u32x4*)(lds + PG_SB(b, h) + boffS + n * 2048); \
        dst[n] = (i32x8){(int)_l.x, (int)_l.y, (int)_l.z, (int)_l.w, (int)_h.x, (int)_h.y, (int)_h.z, (int)_h.w}; } } while (0)
#define PG_MMA(ai, bj, At, Bt) do { __builtin_amdgcn_s_setprio(1); _Pragma("unroll") for (int m = 0; m < 4; ++m) _Pragma("unroll") for (int n = 0; n < 2; ++n) \
        asm volatile("v_mfma_scale_f32_16x16x128_f8f6f4 %0, %1, %2, %0, %3, %3 op_sel_hi:[0,0,0]" : "+v"(acc[ai][bj][m][n]) : "v"(Bt[n]), "v"(At[m]), "v"(scl)); __builtin_amdgcn_s_setprio(0); } while (0)
#define PG_WAIT_V(n) asm volatile("s_waitcnt vmcnt(" #n ")" ::: "memory")
#define PG_WAIT_L(n) asm volatile("s_waitcnt lgkmcnt(" #n ")" ::: "memory")
#define PG_BAR __builtin_amdgcn_s_barrier()
#define PG_SCHED __builtin_amdgcn_sched_barrier(0)
    GUnit cur, nxt; int ui = 0;
    if (!S.next(0, cur)) return;
    unsigned vA00 = G.a_off(cur, sR[0], sC[0]), vA01 = G.a_off(cur, sR[1], sC[1]), vA10 = G.a_off(cur, sR[0] + HALF, sC[0]), vA11 = G.a_off(cur, sR[1] + HALF, sC[1]);
    unsigned vN00 = vA00, vN01 = vA01, vN10 = vA10, vN11 = vA11;
    f32x4 acc[2][2][4][2];
#pragma unroll
    for (int a = 0; a < 2; ++a)
#pragma unroll
        for (int b = 0; b < 2; ++b)
#pragma unroll
            for (int m = 0; m < 4; ++m)
#pragma unroll
                for (int n = 0; n < 2; ++n) acc[a][b][m][n] = (f32x4){0.f, 0.f, 0.f, 0.f};
    i32x8 At[4], B0[2], B1[2];
    { const char* a0 = G.a_tile(cur, 0); const char* b0 = G.b_tile(cur, 0); const char* a1 = G.a_tile(cur, 1); const char* b1 = G.b_tile(cur, 1);
      PG_STAGE(PG_SB(0, 0), b0, voffB); PG_STAGE(PG_SB(0, 1), b0 + bh, voffB); PG_STAGE2(PG_SA(0, 0), a0, vA00, vA01); PG_STAGE2(PG_SA(0, 1), a0, vA10, vA11);
      if (wr == 1) PG_BAR;
      PG_WAIT_V(2); PG_BAR;
      PG_STAGE(PG_SB(1, 0), b1, voffB); PG_STAGE2(PG_SA(1, 0), a1, vA00, vA01); PG_STAGE(PG_SB(1, 1), b1 + bh, voffB);
      PG_WAIT_V(6); PG_BAR; }
    for (;;) {
        const bool has_next = S.next(ui + 1, nxt);
        if constexpr (Src::A_PER_UNIT) {
            if (has_next) { vN00 = G.a_off(nxt, sR[0], sC[0]); vN01 = G.a_off(nxt, sR[1], sC[1]); vN10 = G.a_off(nxt, sR[0] + HALF, sC[0]); vN11 = G.a_off(nxt, sR[1] + HALF, sC[1]); }
        }
        const char* nA0 = has_next ? G.a_tile(nxt, 0) : G.a_tile(cur, 0); const char* nA1 = has_next ? G.a_tile(nxt, 1) : G.a_tile(cur, 1);
        const char* nB0 = has_next ? G.b_tile(nxt, 0) : G.b_tile(cur, 0); const char* nB1 = has_next ? G.b_tile(nxt, 1) : G.b_tile(cur, 1);
        for (int t = 0; t < nt; t += 2) {
            const bool last = (t == nt - 2);
            const char* a1 = G.a_tile(cur, t + 1);
            const char* a2 = last ? nA0 : G.a_tile(cur, t + 2); const char* b2 = last ? nB0 : G.b_tile(cur, t + 2);
            const char* a3 = last ? nA1 : G.a_tile(cur, t + 3); const char* b3 = last ? nB1 : G.b_tile(cur, t + 3);
            PG_LDB(B0, 0, 0); PG_LDB(B1, 0, 1); PG_SCHED; PG_LDA(At, 0, 0); PG_STAGE2(PG_SA(1, 1), a1, vA10, vA11);
            if constexpr (Src::A_PER_UNIT) { vA00 = last ? vN00 : vA00; vA01 = last ? vN01 : vA01; vA10 = last ? vN10 : vA10; vA11 = last ? vN11 : vA11; }
            PG_WAIT_V(8); PG_WAIT_L(0); PG_BAR; PG_MMA(0, 0, At, B0); PG_MMA(0, 1, At, B1); PG_BAR; PG_SCHED;
            PG_LDA(At, 0, 1); PG_STAGE(PG_SB(0, 0), b2, voffB); PG_STAGE(PG_SB(0, 1), b2 + bh, voffB); PG_STAGE2(PG_SA(0, 0), a2, vA00, vA01);
            PG_WAIT_V(8); PG_WAIT_L(0); PG_BAR; PG_MMA(1, 0, At, B0); PG_MMA(1, 1, At, B1); PG_BAR; PG_SCHED;
            PG_LDB(B0, 1, 0); PG_LDB(B1, 1, 1); PG_SCHED; PG_LDA(At, 1, 0); PG_STAGE2(PG_SA(0, 1), a2, vA10, vA11);
            PG_WAIT_V(8); PG_WAIT_L(0); PG_BAR; PG_MMA(0, 0, At, B0); PG_MMA(0, 1, At, B1); PG_BAR; PG_SCHED;
            PG_LDA(At, 1, 1); PG_STAGE(PG_SB(1, 0), b3, voffB); PG_STAGE(PG_SB(1, 1), b3 + bh, voffB); PG_STAGE2(PG_SA(1, 0), a3, vA00, vA01);
            PG_WAIT_V(8); PG_WAIT_L(0); PG_BAR; PG_MMA(1, 0, At, B0); PG_MMA(1, 1, At, B1); PG_BAR; PG_SCHED;
        }
        asm volatile("s_nop 15\n\ts_nop 15" ::: "memory");
        if (wr == 0) PG_BAR;
        E(acc, cur, wr, wc, fr, fq);
        if (!has_next) break;
#pragma unroll
        for (int a = 0; a < 2; ++a)
#pragma unroll
            for (int b = 0; b < 2; ++b)
#pragma unroll
                for (int m = 0; m < 4; ++m)
#pragma unroll
                    for (int n = 0; n < 2; ++n) acc[a][b][m][n] = (f32x4){0.f, 0.f, 0.f, 0.f};
        cur = nxt; ++ui;
        if (wr == 1) PG_BAR;
    }
    PG_WAIT_V(0);
    PG_BAR;
#undef PG_SA
#undef PG_SB
#undef PG_STAGE
#undef PG_STAGE2
#undef PG_LDA
#undef PG_LDB
#undef PG_MMA
#undef PG_WAIT_V
#undef PG_WAIT_L
#undef PG_BAR
#undef PG_SCHED
}

template <class Src, class Epi, class Sched>
__device__ __forceinline__ void gemm_phase_f8m(LAS unsigned char* lds, LAS unsigned char* meta, const Src& G, const Sched& S, const Epi& E) {
    const int tid = threadIdx.x, wid = __builtin_amdgcn_readfirstlane(tid >> 6), lane = tid & 63, wr = wid >> 2, wc = wid & 3, fr = lane & 15, fq = lane >> 4;
    const int nt = G.nt();
    int sR[2], sC[2];
#pragma unroll
    for (int i = 0; i < 2; ++i) stage_rc(tid * 16 + i * 8192, sR[i], sC[i]);
    unsigned voffB[2];
#pragma unroll
    for (int i = 0; i < 2; ++i) { const int Rb = Epi::PERM ? ((sR[i] & ~31) + perm32(sR[i] & 31)) : sR[i]; voffB[i] = G.b_off(Rb, sC[i]); }
    const size_t bh = G.b_hstep();
    const unsigned ldsw = (unsigned)wid * 1024u;
    const int aoff0 = lds_byte(wr * 64 + fr, fq * 16), boff0 = lds_byte(wc * 32 + fr, fq * 16);
    const int aoffF = aoff0 + ((fq & 1) << 4), aoffS = aoff0 + (((fq & 1) ^ 1) << 4), boffF = boff0 + ((fq & 1) << 4), boffS = boff0 + (((fq & 1) ^ 1) << 4);
    const int scl = G.scale_ab();
#define PG_SA(b, h) (((b) * 2 + (h)) * HTB)
#define PG_SB(b, h) ((4 + (b) * 2 + (h)) * HTB)
#define PG_STAGE2(bufoff, gbase, o0, o1) do { \
        __builtin_amdgcn_global_load_lds((const unsigned*)((const char*)(gbase) + (o0)), (LAS unsigned*)(lds + (bufoff) + ldsw), 16, 0, 0); \
        __builtin_amdgcn_global_load_lds((const unsigned*)((const char*)(gbase) + (o1)), (LAS unsigned*)(lds + (bufoff) + ldsw + 8192), 16, 0, 0); } while (0)
#define PG_STAGE(bufoff, gbase, voff) PG_STAGE2(bufoff, gbase, (voff)[0], (voff)[1])
#define PG_LDA(dst, b, h) do { _Pragma("unroll") for (int m = 0; m < 4; ++m) { const u32x4 _l = *(const LAS u32x4*)(lds + PG_SA(b, h) + aoffF + m * 2048), _h = *(const LAS u32x4*)(lds + PG_SA(b, h) + aoffS + m * 2048); \
        dst[m] = (i32x8){(int)_l.x, (int)_l.y, (int)_l.z, (int)_l.w, (int)_h.x, (int)_h.y, (int)_h.z, (int)_h.w}; } } while (0)
#define PG_LDB(dst, b, h) do { _Pragma("unroll") for (int n = 0; n < 2; ++n) { const u32x4 _l = *(const LAS u32x4*)(lds + PG_SB(b, h) + boffF + n * 2048), _h = *(const LAS u32x4*)(lds + PG_SB(b, h) + boffS + n * 2048); \
        dst[n] = (i32x8){(int)_l.x, (int)_l.y, (int)_l.z, (int)_l.w, (int)_h.x, (int)_h.y, (int)_h.z, (int)_h.w}; } } while (0)
#define PG_MMA(ai, bj, At, Bt) do { __builtin_amdgcn_s_setprio(1); _Pragma("unroll") for (int m = 0; m < 4; ++m) _Pragma("unroll") for (int n = 0; n < 2; ++n) \
        asm volatile("v_mfma_scale_f32_16x16x128_f8f6f4 %0, %1, %2, %0, %3, %3 op_sel_hi:[0,0,0]" : "+v"(acc[ai][bj][m][n]) : "v"(Bt[n]), "v"(At[m]), "v"(scl)); __builtin_amdgcn_s_setprio(0); } while (0)
#define PG_WAIT_V(n) asm volatile("s_waitcnt vmcnt(" #n ")" ::: "memory")
#define PG_WAIT_L(n) asm volatile("s_waitcnt lgkmcnt(" #n ")" ::: "memory")
#define PG_BAR __builtin_amdgcn_s_barrier()
#define PG_SCHED __builtin_amdgcn_sched_barrier(0)
#define PG_META(u, slot) do { const int _e = (tid & 255) < (u).nvalid ? (tid & 255) : (u).nvalid - 1; const unsigned* _p = tid < 256 ? (const unsigned*)((u).list + _e) : (const unsigned*)((const float*)(u).A2 + _e); \
        __builtin_amdgcn_global_load_lds(_p, (LAS unsigned*)(meta + (slot) * 3072 + (wid >> 2) * 1024 + (wid & 3) * 256), 4, 0, 0); \
        if (tid < 256) { const unsigned* _b = (const unsigned*)((u).bias + ((tid & 128) ? (u).bstep - 128 : 0) + tid); \
            __builtin_amdgcn_global_load_lds(_b, (LAS unsigned*)(meta + (slot) * 3072 + 2048 + (wid & 3) * 256), 4, 0, 0); } } while (0)
    GUnit cur, nxt; int ui = 0, sl = 0;
    if (!S.next(0, cur)) return;
    PG_META(cur, 0); PG_WAIT_V(0); PG_BAR;
    unsigned vA00 = G.a_offm(meta, sR[0], sC[0]), vA01 = G.a_offm(meta, sR[1], sC[1]), vA10 = G.a_offm(meta, sR[0] + HALF, sC[0]), vA11 = G.a_offm(meta, sR[1] + HALF, sC[1]);
    unsigned vN00 = vA00, vN01 = vA01, vN10 = vA10, vN11 = vA11;
    f32x4 acc[2][2][4][2];
#pragma unroll
    for (int a = 0; a < 2; ++a)
#pragma unroll
        for (int b = 0; b < 2; ++b)
#pragma unroll
            for (int m = 0; m < 4; ++m)
#pragma unroll
                for (int n = 0; n < 2; ++n) acc[a][b][m][n] = (f32x4){0.f, 0.f, 0.f, 0.f};
    i32x8 At[4], B0[2], B1[2];
    { const char* a0 = G.a_tile(cur, 0); const char* b0 = G.b_tile(cur, 0); const char* a1 = G.a_tile(cur, 1); const char* b1 = G.b_tile(cur, 1);
      PG_STAGE(PG_SB(0, 0), b0, voffB); PG_STAGE(PG_SB(0, 1), b0 + bh, voffB); PG_STAGE2(PG_SA(0, 0), a0, vA00, vA01); PG_STAGE2(PG_SA(0, 1), a0, vA10, vA11);
      if (wr == 1) PG_BAR;
      PG_WAIT_V(2); PG_BAR;
      PG_STAGE(PG_SB(1, 0), b1, voffB); PG_STAGE2(PG_SA(1, 0), a1, vA00, vA01); PG_STAGE(PG_SB(1, 1), b1 + bh, voffB);
      PG_WAIT_V(6); PG_BAR; }
    for (;;) {
        const bool has_next = S.next(ui + 1, nxt);
        const int sn = sl == 2 ? 0 : sl + 1;
        if (has_next) PG_META(nxt, sn);
        const char* nA0 = has_next ? G.a_tile(nxt, 0) : G.a_tile(cur, 0); const char* nA1 = has_next ? G.a_tile(nxt, 1) : G.a_tile(cur, 1);
        const char* nB0 = has_next ? G.b_tile(nxt, 0) : G.b_tile(cur, 0); const char* nB1 = has_next ? G.b_tile(nxt, 1) : G.b_tile(cur, 1);
        for (int t = 0; t < nt; t += 2) {
            const bool last = (t == nt - 2);
            const char* a1 = G.a_tile(cur, t + 1);
            const char* a2 = last ? nA0 : G.a_tile(cur, t + 2); const char* b2 = last ? nB0 : G.b_tile(cur, t + 2);
            const char* a3 = last ? nA1 : G.a_tile(cur, t + 3); const char* b3 = last ? nB1 : G.b_tile(cur, t + 3);
            PG_LDB(B0, 0, 0); PG_LDB(B1, 0, 1); PG_SCHED; PG_LDA(At, 0, 0); PG_STAGE2(PG_SA(1, 1), a1, vA10, vA11);
            if constexpr (Src::A_PER_UNIT) { if (last && has_next) { LAS unsigned char* mn = meta + sn * 3072;
                vA00 = G.a_offm(mn, sR[0], sC[0]); vA01 = G.a_offm(mn, sR[1], sC[1]); vA10 = G.a_offm(mn, sR[0] + HALF, sC[0]); vA11 = G.a_offm(mn, sR[1] + HALF, sC[1]); } }
            PG_WAIT_V(8); PG_WAIT_L(0); PG_BAR; PG_MMA(0, 0, At, B0); PG_MMA(0, 1, At, B1); PG_BAR; PG_SCHED;
            PG_LDA(At, 0, 1); PG_STAGE(PG_SB(0, 0), b2, voffB); PG_STAGE(PG_SB(0, 1), b2 + bh, voffB); PG_STAGE2(PG_SA(0, 0), a2, vA00, vA01);
            PG_WAIT_V(8); PG_WAIT_L(0); PG_BAR; PG_MMA(1, 0, At, B0); PG_MMA(1, 1, At, B1); PG_BAR; PG_SCHED;
            PG_LDB(B0, 1, 0); PG_LDB(B1, 1, 1); PG_SCHED; PG_LDA(At, 1, 0); PG_STAGE2(PG_SA(0, 1), a2, vA10, vA11);
            PG_WAIT_V(8); PG_WAIT_L(0); PG_BAR; PG_MMA(0, 0, At, B0); PG_MMA(0, 1, At, B1); PG_BAR; PG_SCHED;
            PG_LDA(At, 1, 1); PG_STAGE(PG_SB(1, 0), b3, voffB); PG_STAGE(PG_SB(1, 1), b3 + bh, voffB); PG_STAGE2(PG_SA(1, 0), a3, vA00, vA01);
            PG_WAIT_V(8); PG_WAIT_L(0); PG_BAR; PG_MMA(1, 0, At, B0); PG_MMA(1, 1, At, B1); PG_BAR; PG_SCHED;
        }
        asm volatile("s_nop 15\n\ts_nop 15" ::: "memory");
        if (wr == 0) PG_BAR;
        E(acc, cur, wr, wc, fr, fq, meta + sl * 3072);
        if (!has_next) break;
#pragma unroll
        for (int a = 0; a < 2; ++a)
#pragma unroll
            for (int b = 0; b < 2; ++b)
#pragma unroll
                for (int m = 0; m < 4; ++m)
#pragma unroll
                    for (int n = 0; n < 2; ++n) acc[a][b][m][n] = (f32x4){0.f, 0.f, 0.f, 0.f};
        cur = nxt; ++ui; sl = sn;
        if (wr == 1) PG_BAR;
    }
    PG_WAIT_V(0);
    PG_BAR;
#undef PG_META
#undef PG_SA
#undef PG_SB
#undef PG_STAGE
#undef PG_STAGE2
#undef PG_LDA
#undef PG_LDB
#undef PG_MMA
#undef PG_WAIT_V
#undef PG_WAIT_L
#undef PG_BAR
#undef PG_SCHED
}

struct SrcPlain {
    static constexpr bool A_PER_UNIT = false;
    int K;
    __device__ __forceinline__ int nt() const { return K / BK; }
    __device__ __forceinline__ const char* a_tile(const GUnit& u, int t) const { return u.A + (size_t)t * (BK * 2); }
    __device__ __forceinline__ const char* b_tile(const GUnit& u, int t) const { return u.B + (size_t)t * (BK * 2); }
    __device__ __forceinline__ unsigned a_off(const GUnit&, int R, int C) const { return (unsigned)(R * K + C) * 2u; }
    __device__ __forceinline__ unsigned b_off(int R, int C) const { return (unsigned)(R * K + C) * 2u; }
    __device__ __forceinline__ size_t b_hstep() const { return (size_t)HALF * K * 2; }
};
struct SrcGather {
    static constexpr bool A_PER_UNIT = true;
    int K;
    __device__ __forceinline__ int nt() const { return K / BK; }
    __device__ __forceinline__ const char* a_tile(const GUnit& u, int t) const { return u.A + (size_t)t * (BK * 2); }
    __device__ __forceinline__ const char* b_tile(const GUnit& u, int t) const { return u.B + (size_t)t * (BK * 2); }
    __device__ __forceinline__ unsigned a_off(const GUnit& u, int R, int C) const { const int rr = R < u.nvalid ? R : u.nvalid - 1; const int tok = u.list[rr] >> 2; return (unsigned)(tok * K + C) * 2u; }
    __device__ __forceinline__ unsigned b_off(int R, int C) const { return (unsigned)(R * K + C) * 2u; }
    __device__ __forceinline__ size_t b_hstep() const { return (size_t)HALF * K * 2; }
};
struct SrcPlain8 {
    static constexpr bool A_PER_UNIT = false;
    __device__ __forceinline__ unsigned a_offm(LAS unsigned char*, int R, int C) const { return (unsigned)(R * Kb + 2 * C); }
    int Kb, wexp;
    __device__ __forceinline__ int nt() const { return Kb / 128; }
    __device__ __forceinline__ int scale_ab() const { const int e = 127 - wexp / 2; return e | (e << 8) | (e << 16) | (e << 24); }
    __device__ __forceinline__ const char* a_tile(const GUnit& u, int t) const { return u.A + (size_t)t * 128; }
    __device__ __forceinline__ const char* b_tile(const GUnit& u, int t) const { return u.B + (size_t)t * 128; }
    __device__ __forceinline__ unsigned a_off(const GUnit&, int R, int C) const { return (unsigned)(R * Kb + 2 * C); }
    __device__ __forceinline__ unsigned b_off(int R, int C) const { return (unsigned)(R * Kb + 2 * C); }
    __device__ __forceinline__ size_t b_hstep() const { return (size_t)HALF * Kb; }
};
struct SrcGather8 {
    static constexpr bool A_PER_UNIT = true;
    __device__ __forceinline__ unsigned a_offm(LAS unsigned char* mslot, int R, int C) const { const int tok = ((LAS int*)mslot)[R] >> 2; return (unsigned)(tok * Kb + 2 * C); }
    int Kb, wexp;
    __device__ __forceinline__ int nt() const { return Kb / 128; }
    __device__ __forceinline__ int scale_ab() const { const int e = 127 - wexp / 2; return e | (e << 8) | (e << 16) | (e << 24); }
    __device__ __forceinline__ const char* a_tile(const GUnit& u, int t) const { return u.A + (size_t)t * 128; }
    __device__ __forceinline__ const char* b_tile(const GUnit& u, int t) const { return u.B + (size_t)t * 128; }
    __device__ __forceinline__ unsigned a_off(const GUnit& u, int R, int C) const { const int rr = R < u.nvalid ? R : u.nvalid - 1; const int tok = u.list[rr] >> 2; return (unsigned)(tok * Kb + 2 * C); }
    __device__ __forceinline__ unsigned b_off(int R, int C) const { return (unsigned)(R * Kb + 2 * C); }
    __device__ __forceinline__ size_t b_hstep() const { return (size_t)HALF * Kb; }
};
}
#define XB_TMO      128
#define XB_XCNT(j)  (256  + 64 * (j))
#define XB_XSUB(j)  (1280 + 64 * (j))
#define XB_XGEN(j)  (2304 + 64 * (j))
#define XB_TOP      3328
#define XB_TOPGEN   3392
#define XCD_BAR_WORDS 3456
#define XB_SPIN_CAP (1u << 18)

__device__ __forceinline__ unsigned xb_ld(unsigned* p)              { return __hip_atomic_load(p, __ATOMIC_RELAXED, __HIP_MEMORY_SCOPE_AGENT); }
__device__ __forceinline__ unsigned xb_add(unsigned* p, unsigned v) { return __hip_atomic_fetch_add(p, v, __ATOMIC_RELAXED, __HIP_MEMORY_SCOPE_AGENT); }
__device__ __forceinline__ unsigned xb_xcc_id() { return (unsigned)__builtin_amdgcn_s_getreg((3 << 11) | 20) & 0xFu; }
#define XB_SPIN(cond, bar) do { unsigned _sp = 0; while (cond) { __builtin_amdgcn_s_sleep(1); \
    if ((++_sp & 255u) == 0u) { if (xb_ld(&(bar)[XB_TMO])) break; if (_sp > XB_SPIN_CAP) { atomicAdd(&(bar)[XB_TMO], 1u); break; } } } } while (0)

struct XcdBarrier {
    unsigned* bar; unsigned x;
    volatile LAS unsigned* st;
};

__device__ __forceinline__ XcdBarrier xcd_barrier_post(unsigned* bar, volatile LAS unsigned* st) {
    XcdBarrier b; b.bar = bar; b.x = xb_xcc_id(); b.st = st;
    if (threadIdx.x == 0) (void)xb_add(&bar[XB_XCNT(b.x)], 1u);
    return b;
}
__device__ __forceinline__ void xcd_barrier_complete(unsigned* bar, unsigned x, unsigned& nloc, unsigned& nx) {
    const unsigned G = gridDim.x * gridDim.y * gridDim.z;
    unsigned sum, cnt, mine, sp = 0u;
    for (;;) {
        sum = 0u; cnt = 0u; mine = 0u;
#pragma unroll
        for (unsigned j = 0; j < 16; ++j) { const unsigned c = xb_ld(&bar[XB_XCNT(j)]); sum += c; cnt += (c > 0u) ? 1u : 0u; mine = (j == x) ? c : mine; }
        if (sum == G) break;
        __builtin_amdgcn_s_sleep(1);
        if ((++sp & 255u) == 0u) { if (xb_ld(&bar[XB_TMO])) break; if (sp > XB_SPIN_CAP) { atomicAdd(&bar[XB_TMO], 1u); break; } }
    }
    nloc = mine > 0u ? mine : 1u; nx = cnt > 0u ? cnt : 1u;
}

__device__ __forceinline__ void xcd_barrier(const XcdBarrier& b) {
    asm volatile("s_waitcnt vmcnt(0)" ::: "memory");
    __syncthreads();
    if (threadIdx.x == 0) {
        unsigned* bar = b.bar;
        __builtin_amdgcn_s_waitcnt(0);
        unsigned nloc = b.st[0], nx = b.st[1];
        if (nloc == 0u) { xcd_barrier_complete(bar, b.x, nloc, nx); b.st[0] = nloc; b.st[1] = nx; }
        const unsigned old = xb_add(&bar[XB_XSUB(b.x)], 1u);
        const unsigned gen = old / nloc;
        if (old + 1u == (gen + 1u) * nloc) {
            __builtin_amdgcn_fence(__ATOMIC_RELEASE, "agent");
            asm volatile("s_waitcnt vmcnt(0)" ::: "memory");
            const unsigned og = xb_add(&bar[XB_TOP], 1u);
            const unsigned tg = og / nx;
            if (og + 1u == (tg + 1u) * nx) xb_add(&bar[XB_TOPGEN], 1u);
            else XB_SPIN(xb_ld(&bar[XB_TOPGEN]) == tg, bar);
            __builtin_amdgcn_fence(__ATOMIC_ACQUIRE, "agent");
            xb_add(&bar[XB_XGEN(b.x)], 1u);
            asm volatile("s_waitcnt vmcnt(0)" ::: "memory");
        } else {
            XB_SPIN(xb_ld(&bar[XB_XGEN(b.x)]) == gen, bar);
            __builtin_amdgcn_fence(__ATOMIC_ACQUIRE, "agent");
            asm volatile("s_waitcnt vmcnt(0)" ::: "memory");
        }
    }
    __syncthreads();
}
constexpr int CW_GRP = 3072  , CW_PLACE = 3648  ;
__device__ __forceinline__ void group_barrier(unsigned* ctl, int bid, unsigned target) {
    asm volatile("s_waitcnt vmcnt(0)" ::: "memory");
    __syncthreads();
    if (threadIdx.x == 0) {
        unsigned* c = ctl + CW_GRP + 64 * (bid & 7);
        (void)xb_add(c, 1u);
        unsigned sp = 0;
        while (xb_ld(c) < target) { __builtin_amdgcn_s_sleep(1);
            if ((++sp & 255u) == 0u) { if (xb_ld(&ctl[CW_BAR + XB_TMO])) break; if (sp > XB_SPIN_CAP) { atomicAdd(&ctl[CW_BAR + XB_TMO], 1u); break; } } }
        __builtin_amdgcn_fence(__ATOMIC_ACQUIRE, "agent");
        asm volatile("s_waitcnt vmcnt(0)" ::: "memory");
    }
    __syncthreads();
}
constexpr int NWAVES = 8;
constexpr int RING_BYTES = 131072, MISC_OFF = RING_BYTES + 320, META_OFF = RING_BYTES + 1024  , LDS_BYTES = 147456;
struct Frame {
    LAS unsigned char* lds; volatile LAS unsigned* MISC;
    unsigned* ctl;
    int tid, lane, wave, G, bid;
    const float *x, *norm_mix, *w_in, *lam_re, *lam_im, *b_re, *b_im, *c_re, *c_im, *s5d, *log_step, *w_glu, *w_bsb, *w_bs5, *w_out, *norm_ffn, *w_router, *b_router, *w_up, *b_up, *w_down, *b_down, *norm_final;
    float* out; unsigned char* ws;
    float *RSTD1, *RSTD2, *GATEL, *SS2P, *SLOC; int *RB, *LIST;
    bf16_t *X1BF, *XB, *QB, *KB, *VT, *UB, *GSB, *GS5, *YSB, *Y2, *YS5, *MRG, *X1B, *ACT, *YSLOT, *WIN, *WGLU, *WBSB, *WBS5, *WOUT, *WR, *M1T, *YT, *SIN, *WUP, *WDN;
};

__device__ __forceinline__ void p0_tr_item(const float* __restrict__ W, int ldw, int K, const float* __restrict__ kscale, bf16_t* __restrict__ WT, int k0, int n0, int drow0, LAS unsigned* scr, int lane) {
    const int q = lane >> 4, a = lane & 15;
    f32x4 v0[8], v1[8];
#pragma unroll
    for (int i = 0; i < 8; ++i) { const int kk = k0 + 8 * i + 2 * q;
        v0[i] = *(const f32x4*)(W + (size_t)kk * ldw + n0 + 4 * a); v1[i] = *(const f32x4*)(W + (size_t)(kk + 1) * ldw + n0 + 4 * a); }
#pragma unroll
    for (int i = 0; i < 8; ++i) { const int kl = 8 * i + 2 * q; float s0 = 1.f, s1 = 1.f; if (kscale) { s0 = kscale[k0 + kl]; s1 = kscale[k0 + kl + 1]; }
#pragma unroll
        for (int j = 0; j < 4; ++j) scr[(4 * a + j) * 33 + (kl >> 1)] = cvt_pk_bf16(v0[i][j] * s0, v1[i][j] * s1); }
    asm volatile("s_waitcnt lgkmcnt(0)" ::: "memory");
    const int c = lane & 7;
#pragma unroll
    for (int i2 = 0; i2 < 8; ++i2) { const int row = (lane >> 3) + 8 * i2; u32x4 o;
        o.x = scr[row * 33 + 4 * c]; o.y = scr[row * 33 + 4 * c + 1]; o.z = scr[row * 33 + 4 * c + 2]; o.w = scr[row * 33 + 4 * c + 3];
        *(u32x4*)(WT + (size_t)(drow0 + row) * K + k0 + 8 * c) = o; }
    asm volatile("s_waitcnt lgkmcnt(0)" ::: "memory");
}
__device__ __forceinline__ unsigned pk4_fp8(float a, float b, float c, float d) {
    a = __builtin_fminf(__builtin_fmaxf(a, -448.f), 448.f); b = __builtin_fminf(__builtin_fmaxf(b, -448.f), 448.f); c = __builtin_fminf(__builtin_fmaxf(c, -448.f), 448.f); d = __builtin_fminf(__builtin_fmaxf(d, -448.f), 448.f);
    int w = __builtin_amdgcn_cvt_pk_fp8_f32(a, b, 0, false); w = __builtin_amdgcn_cvt_pk_fp8_f32(c, d, w, true); return (unsigned)w;
}
__device__ __forceinline__ unsigned pk4_fp8_nc(float a, float b, float c, float d) {
    int w = __builtin_amdgcn_cvt_pk_fp8_f32(a, b, 0, false); w = __builtin_amdgcn_cvt_pk_fp8_f32(c, d, w, true); return (unsigned)w;
}
__device__ __forceinline__ void p0_tr_item8(const float* __restrict__ W, int ldw, int K, const float* __restrict__ kscale, float wmul, unsigned char* __restrict__ WT, int k0, int n0, int drow0, LAS unsigned* scr, int lane) {
    const int q = lane >> 4, a = lane & 15;
    f32x4 v[4][4];
#pragma unroll
    for (int i = 0; i < 4; ++i)
#pragma unroll
        for (int r = 0; r < 4; ++r) v[i][r] = *(const f32x4*)(W + (size_t)(k0 + 16 * i + 4 * q + r) * ldw + n0 + 4 * a);
#pragma unroll
    for (int i = 0; i < 4; ++i) { float s[4];
#pragma unroll
        for (int r = 0; r < 4; ++r) s[r] = kscale ? kscale[k0 + 16 * i + 4 * q + r] * wmul : wmul;
#pragma unroll
        for (int j = 0; j < 4; ++j) scr[(4 * a + j) * 17 + 4 * i + q] = pk4_fp8(v[i][0][j] * s[0], v[i][1][j] * s[1], v[i][2][j] * s[2], v[i][3][j] * s[3]); }
    asm volatile("s_waitcnt lgkmcnt(0)" ::: "memory");
    const int c = lane & 3;
#pragma unroll
    for (int i2 = 0; i2 < 4; ++i2) { const int row = (lane >> 2) + 16 * i2; u32x4 o;
        o.x = scr[row * 17 + 4 * c]; o.y = scr[row * 17 + 4 * c + 1]; o.z = scr[row * 17 + 4 * c + 2]; o.w = scr[row * 17 + 4 * c + 3];
        *(u32x4*)(WT + (size_t)(drow0 + row) * K + k0 + 16 * c) = o; }
    asm volatile("s_waitcnt lgkmcnt(0)" ::: "memory");
}
__device__ __forceinline__ void cpow_lam(float lr, float li, float step, float& br, float& bi) { const float mag = expf(lr * step); float sn, cs; sincosf(li * step, &sn, &cs); br = mag * cs; bi = mag * sn; }

__device__ __forceinline__ void p0_s5_tables(Frame& F, int g) {
    LAS float* pwr = (LAS float*)F.lds;
    LAS float* pwi = pwr + 17 * 64;
    LAS float* bbr = pwi + 17 * 64;
    LAS float* bbi = bbr + 1024;
    LAS float* Cr = bbi + 1024;
    LAS float* Ci = Cr + 1024;
    LAS float* Kt = Ci + 1024;
    const int tid = F.tid; const float step = expf(F.log_step[g]);
    if (tid < 64) { const int p = tid; float br, bi; cpow_lam(F.lam_re[g * S5P + p], F.lam_im[g * S5P + p], step, br, bi); float r = 1.f, im = 0.f;
        for (int n = 0; n <= 16; ++n) { pwr[n * 64 + p] = r; pwi[n * 64 + p] = im; const float nr = r * br - im * bi, ni = r * bi + im * br; r = nr; im = ni; } }
#pragma unroll
    for (int rep = 0; rep < 2; ++rep) { const int idx = tid + 512 * rep, p = idx >> 4, h = idx & 15;
        const float lr = F.lam_re[g * S5P + p], li = F.lam_im[g * S5P + p]; float br, bi; cpow_lam(lr, li, step, br, bi);
        const float nr = br - 1.0f, ni = bi, den = lr * lr + li * li, fr = (nr * lr + ni * li) / den, fi = (ni * lr - nr * li) / den;
        const float b0 = F.b_re[(g * S5P + p) * S5H + h], b1 = F.b_im[(g * S5P + p) * S5H + h];
        bbr[p * 16 + h] = fr * b0 - fi * b1; bbi[p * 16 + h] = fr * b1 + fi * b0;
        Cr[idx] = F.c_re[g * 1024 + idx]; Ci[idx] = F.c_im[g * 1024 + idx]; }
    __syncthreads();
#pragma unroll 1
    for (int rep = 0; rep < 8; ++rep) { const int idx = tid + 512 * rep, tau = idx >> 8, h = (idx >> 4) & 15, h2 = idx & 15; float s = 0.f;
        for (int p = 0; p < 64; ++p) { const float cr = Cr[h * 64 + p], ci = Ci[h * 64 + p], pr = pwr[tau * 64 + p], pi = pwi[tau * 64 + p];
            const float xr = cr * pr - ci * pi, xi = cr * pi + ci * pr; s += xr * bbr[p * 16 + h2] - xi * bbi[p * 16 + h2]; }
        if (tau == 0 && h == h2) s += F.s5d[g * S5H + h];
        Kt[idx] = s; }
    __syncthreads();
    unsigned* YT32 = (unsigned*)(F.YT + (size_t)g * 256 * 384);
#pragma unroll 1
    for (int idx = tid; idx < 256 * 192; idx += 512) { const int row = idx / 192, cp = idx % 192, i = row >> 4, h = row & 15; float v[2];
#pragma unroll
        for (int e = 0; e < 2; ++e) { const int col = 2 * cp + e;
            if (col < 256) { const int j = col >> 4, h2 = col & 15; v[e] = (j <= i) ? Kt[(i - j) * 256 + h * 16 + h2] : 0.f; }
            else { const int n = col - 256, p = n & 63; const float cr = Cr[h * 64 + p], ci = Ci[h * 64 + p], pr = pwr[(i + 1) * 64 + p], pi = pwi[(i + 1) * 64 + p];
                v[e] = (n < 64) ? (cr * pr - ci * pi) : -(cr * pi + ci * pr); } }
        YT32[idx] = cvt_pk_bf16(v[0], v[1]); }
    unsigned* M32 = (unsigned*)(F.M1T + (size_t)g * 256 * 256);
#pragma unroll 1
    for (int idx = tid; idx < 256 * 128; idx += 512) { const int row = idx >> 7, cp = idx & 127; float v[2] = {0.f, 0.f};
        if (row < 128) { const int p = row & 63;
#pragma unroll
            for (int e = 0; e < 2; ++e) { const int k = 2 * cp + e, j = k >> 4, h2 = k & 15; const float pr = pwr[(15 - j) * 64 + p], pi = pwi[(15 - j) * 64 + p], br = bbr[p * 16 + h2], bi = bbi[p * 16 + h2];
                v[e] = (row < 64) ? (pr * br - pi * bi) : (pr * bi + pi * br); } }
        M32[idx] = cvt_pk_bf16(v[0], v[1]); }
    __syncthreads();
}

__device__ __forceinline__ void p0_prologue(Frame& F) {
    if (F.bid < S5G) p0_s5_tables(F, F.bid);
    const int gw = F.bid * NWAVES + F.wave, NGW = F.G * NWAVES, lane = F.lane;
    for (int m = gw; m < T; m += 2 * NGW) {
        const int m2 = m + NGW; const bool two = m2 < T;
        const f32x4* xr = (const f32x4*)(F.x + (size_t)m * D) + lane; const f32x4* xr2 = (const f32x4*)(F.x + (size_t)(two ? m2 : m) * D) + lane; f32x4 v[4], w[4]; float s = 0.f, s2 = 0.f;
#pragma unroll
        for (int j = 0; j < 4; ++j) { v[j] = __builtin_nontemporal_load(xr + 64 * j); w[j] = __builtin_nontemporal_load(xr2 + 64 * j); }
#pragma unroll
        for (int j = 0; j < 4; ++j) { s += (v[j].x * v[j].x + v[j].y * v[j].y) + (v[j].z * v[j].z + v[j].w * v[j].w); s2 += (w[j].x * w[j].x + w[j].y * w[j].y) + (w[j].z * w[j].z + w[j].w * w[j].w); }
        s = wave_sum(s); s2 = wave_sum(s2);
        if (lane == 0) { F.RSTD1[m] = rsqrtf(s * (1.0f / D) + RMS_EPS); if (two) F.RSTD1[m2] = rsqrtf(s2 * (1.0f / D) + RMS_EPS); }
        u32x2* o = (u32x2*)(F.XB + (size_t)m * D) + lane; u32x2* o2 = (u32x2*)(F.XB + (size_t)m2 * D) + lane;
#pragma unroll
        for (int j = 0; j < 4; ++j) { u32x2 q; q.x = cvt_pk_bf16(v[j].x, v[j].y); q.y = cvt_pk_bf16(v[j].z, v[j].w); o[64 * j] = q; if (two) { u32x2 q2; q2.x = cvt_pk_bf16(w[j].x, w[j].y); q2.y = cvt_pk_bf16(w[j].z, w[j].w); o2[64 * j] = q2; } }
    }
    for (int idx = gw * 64 + lane; idx < NE * D; idx += NGW * 64) { const int e = idx >> 10, k = idx & 1023; const float w = F.norm_ffn[k] * F.w_router[k * NE + e];
        const int wo = ((((k >> 4) * 2 + ((k >> 3) & 1)) * NE + e) << 3) | (k & 7);
        const bf16_t hi = f2bf(w); F.WR[wo] = hi; F.WR[NE * D + wo] = f2bf(w - bf2f(hi)); }
    LAS unsigned* scr = (LAS unsigned*)(F.lds + 49152 + F.wave * 8448);
    constexpr int I_IN = 16 * 64, I_GLU = 8 * 8, I_BR = 8 * 16, I_OUT = 16 * 16;
    constexpr int NITEMS = I_IN + I_GLU + 2 * I_BR + I_OUT;
    for (int it = gw; it < NITEMS; it += NGW) {
        int r = it;
        if (r < I_IN) { const int kb = r >> 6, nb = r & 63, n0 = nb * 64;
            const int drow = n0 < OFF_V ? n0 : (n0 < OFF_U ? 3584 + (n0 - OFF_V) : n0 - 512);
            p0_tr_item(F.w_in, INW, D, F.norm_mix, F.WIN, kb * 64, n0, drow, scr, lane); continue; } r -= I_IN;
        if (r < I_GLU) { p0_tr_item(F.w_glu, S5W, S5W, nullptr, F.WGLU, (r >> 3) * 64, (r & 7) * 64, (r & 7) * 64, scr, lane); continue; } r -= I_GLU;
        if (r < I_BR) { p0_tr_item(F.w_bsb, D, SBW, nullptr, F.WBSB, (r >> 4) * 64, (r & 15) * 64, (r & 15) * 64, scr, lane); continue; } r -= I_BR;
        if (r < I_BR) { p0_tr_item(F.w_bs5, D, S5W, nullptr, F.WBS5, (r >> 4) * 64, (r & 15) * 64, (r & 15) * 64, scr, lane); continue; } r -= I_BR;
        p0_tr_item(F.w_out, D, D, nullptr, F.WOUT, (r >> 4) * 64, (r & 15) * 64, (r & 15) * 64, scr, lane);
    }
}
constexpr int I_UP = NE * 16 * 32, I_DN = NE * 16 * 16;
struct CvtItem { const float* W; const float* ks; unsigned char* WT; int ldw, K, k0, n0, drow0; float kf; };
__device__ __forceinline__ CvtItem cvt_decode(const Frame& F, int r) {
    CvtItem c;
    if (r < I_UP) { const int e = r >> 9, kb = ((r >> 8) & 1) * 8 + (r & 7), nb = (r >> 3) & 31, n0 = nb * 64,     j0 = n0 & 1023, lin = n0 >> 10;
        c.W = F.w_up + (size_t)e * D * 2 * DFF; c.ks = F.norm_ffn; c.kf = 1.f; c.WT = (unsigned char*)F.WUP + (size_t)e * 2 * DFF * D * (MOE_FP8 ? 1 : 2); c.ldw = 2 * DFF; c.K = D; c.k0 = kb * 64; c.n0 = n0; c.drow0 = 256 * (j0 >> 7) + 128 * lin + (j0 & 127); }
    else { r -= I_UP; const int e = r >> 8, kb = ((r >> 7) & 1) * 8 + (r & 7), nb = (r >> 3) & 15;
        c.W = F.w_down + (size_t)e * DFF * D; c.ks = F.norm_ffn; c.kf = 0.f; c.WT = (unsigned char*)F.WDN + (size_t)e * D * DFF * (MOE_FP8 ? 1 : 2); c.ldw = D; c.K = DFF; c.k0 = kb * 64; c.n0 = nb * 64; c.drow0 = nb * 64; }
    return c;
}
#if MOE_FP8
struct CvtRegs { f32x4 v[4][4]; };
__device__ __forceinline__ void cvt_load(const CvtItem& c, CvtRegs& R, int lane) {
    const int q = lane >> 4, a = lane & 15;
#pragma unroll
    for (int i = 0; i < 4; ++i)
#pragma unroll
        for (int r = 0; r < 4; ++r) R.v[i][r] = __builtin_nontemporal_load((const f32x4*)(c.W + (size_t)(c.k0 + 16 * i + 4 * q + r) * c.ldw + c.n0 + 4 * a));
}
__device__ __forceinline__ void cvt_finish(const CvtItem& c, const CvtRegs& R, LAS unsigned* scr, int lane) {
    const int q = lane >> 4, a = lane & 15;
#pragma unroll
    for (int i = 0; i < 4; ++i)
#pragma unroll
        for (int j = 0; j < 4; ++j) scr[(4 * a + j) * 17 + 4 * i + q] = pk4_fp8(R.v[i][0][j] * 64.f, R.v[i][1][j] * 64.f, R.v[i][2][j] * 64.f, R.v[i][3][j] * 64.f);
    asm volatile("s_waitcnt lgkmcnt(0)" ::: "memory");
    const int cc = lane & 3;
#pragma unroll
    for (int i2 = 0; i2 < 4; ++i2) { const int row = (lane >> 2) + 16 * i2; u32x4 o;
        o.x = scr[row * 17 + 4 * cc]; o.y = scr[row * 17 + 4 * cc + 1]; o.z = scr[row * 17 + 4 * cc + 2]; o.w = scr[row * 17 + 4 * cc + 3];
        *(u32x4*)(c.WT + (size_t)(c.drow0 + row) * c.K + c.k0 + 16 * cc) = o; }
    asm volatile("s_waitcnt lgkmcnt(0)" ::: "memory");
}
__device__ __forceinline__ void cvt_run(Frame& F, int first, int stride, int n, LAS unsigned* scr) {
    CvtRegs Ra, Rb, Rc; CvtItem ca = cvt_decode(F, first), cb = ca, cc = ca;
    cvt_load(ca, Ra, F.lane);
    if (n > 1) { cb = cvt_decode(F, first + stride); cvt_load(cb, Rb, F.lane); }
    for (int j = 0; j < n; j += 3) {
        if (j + 2 < n) { cc = cvt_decode(F, first + (j + 2) * stride); cvt_load(cc, Rc, F.lane); }
        cvt_finish(ca, Ra, scr, F.lane);
        if (j + 3 < n) { ca = cvt_decode(F, first + (j + 3) * stride); cvt_load(ca, Ra, F.lane); }
        if (j + 1 < n) cvt_finish(cb, Rb, scr, F.lane);
        if (j + 4 < n) { cb = cvt_decode(F, first + (j + 4) * stride); cvt_load(cb, Rb, F.lane); }
        if (j + 2 < n) cvt_finish(cc, Rc, scr, F.lane);
    }
}
#endif
__device__ __forceinline__ void cvt_expert_item(Frame& F, int r, LAS unsigned* scr) {
    const CvtItem c = cvt_decode(F, r);
#if MOE_FP8
    p0_tr_item8(c.W, c.ldw, c.K, nullptr, 64.f, c.WT, c.k0, c.n0, c.drow0, scr, F.lane);
#else
    p0_tr_item(c.W, c.ldw, c.K, c.kf != 0.f ? c.ks : nullptr, (bf16_t*)c.WT, c.k0, c.n0, c.drow0, scr, F.lane);
#endif
}
__device__ __forceinline__ void cvt_expert_items(Frame& F, int part = 0, int nparts = 1, int pend = -1) {
    LAS unsigned* scr = (LAS unsigned*)(F.lds + F.wave * 8448);
#if MOE_FP8
    if (F.G == 256) {
        int first, stride, n;
        if (F.bid < S5G) { first = F.bid * 8 + F.wave; stride = 256; n = 8; }
        else { const int w = (F.bid - S5G) * 8 + F.wave, NW = (256 - S5G) * 8, total = I_UP + I_DN - 2048; first = 2048 + w; stride = NW; n = total / NW + (w < total % NW ? 1 : 0); }
        const int j0 = n * part / nparts, j1 = n * (pend < 0 ? part + 1 : pend) / nparts;
        if (j1 > j0) cvt_run(F, first + j0 * stride, stride, j1 - j0, scr);
        return; }
#endif
    if (part == 0) for (int r = F.bid * NWAVES + F.wave; r < I_UP + I_DN; r += F.G * NWAVES) cvt_expert_item(F, r, scr);
}

constexpr int CVT_NS = 8, CVT_NT = 4, CVT_HOLES = S5G * (8 - CVT_NT)  , CVT_POOL = CVT_HOLES + (I_UP + I_DN) / 8 - 2048  ;
#if MOE_FP8
__device__ __forceinline__ int cvt_pool_row(int q) { return q < CVT_HOLES ? (CVT_NT + (q >> 5)) * 256 + (q & 31) : 2048 + (q - CVT_HOLES); }
__device__ __forceinline__ void cvt_run3(Frame& F, int ra, int rb, int rc, LAS unsigned* scr) {
    CvtRegs Ra, Rb, Rc; const CvtItem ca = cvt_decode(F, ra), cb = cvt_decode(F, rb), cc = cvt_decode(F, rc);
    cvt_load(ca, Ra, F.lane); cvt_load(cb, Rb, F.lane); cvt_load(cc, Rc, F.lane);
    cvt_finish(ca, Ra, scr, F.lane); cvt_finish(cb, Rb, scr, F.lane); cvt_finish(cc, Rc, scr, F.lane);
}
#endif
__device__ __forceinline__ void cvt_expert_dyn(Frame& F, unsigned* queue) {
#if MOE_FP8
    if (F.G == 256) {
        LAS unsigned* scr = (LAS unsigned*)(F.lds + F.wave * 8448);
        if (F.tid == 0) F.MISC[4] = atomicAdd(queue, 1u);
        cvt_run(F, F.bid * 8 + F.wave, 2048, F.bid < S5G ? CVT_NT : CVT_NS, scr);
        __syncthreads();
        unsigned q0 = F.MISC[4]; int slot = 0;
        while (q0 < (unsigned)CVT_POOL) {
            if (F.tid == 0) F.MISC[5 - slot] = atomicAdd(queue, 1u);
            cvt_run(F, cvt_pool_row((int)q0) * 8 + F.wave, 0, 1, scr);
            __syncthreads();
            slot ^= 1; q0 = F.MISC[4 + slot];
        }
        return;
    }
#endif
    cvt_expert_items(F);
}

__device__ __forceinline__ void cvt_expert_queue(Frame& F, unsigned* queue) {
#if MOE_FP8
    LAS unsigned* scr = (LAS unsigned*)(F.lds + F.wave * 8448);
    for (;;) {
        unsigned r = 0; if (F.lane == 0) r = atomicAdd(queue, 4u);
        r = (unsigned)__builtin_amdgcn_readfirstlane((int)r);
        if (r >= (unsigned)(I_UP + I_DN)) break;
        cvt_run(F, (int)r, 1, 4, scr);
    }
#else
    cvt_expert_items(F);
#endif
}

struct SchedP1 {
    int G, c; const char* XB; const char* WIN; int i0, i1;
    __device__ __forceinline__ bool next(int i, pg::GUnit& u) const {
        i += i0; if (i >= i1) return false;
        const int L = i * G + c; if (L >= 1024) return false;
        u.A2 = nullptr; u.list = nullptr; u.x1 = 0; u.nvalid = 256;
        if (L < 896) { const int w = (L & 7) * 112 + (L >> 3), gid = w / 112, rem = w % 112; u.pm = gid * 8 + (rem & 7); u.pn = rem >> 3; u.x0 = 0;
            u.A = XB + (size_t)u.pm * 256 * 2048; u.B = WIN + (size_t)u.pn * 256 * 2048; }
        else { const int l = L - 896; u.pm = l >> 6; u.pn = l & 63; u.x0 = 1; u.A = WIN + (size_t)(3584 + u.pm * 256) * 2048; u.B = XB + (size_t)u.pn * 256 * 2048; }
        return true;
    }
};
struct EpiInProj {
    static constexpr bool PERM = true;
    const float* rstd1; bf16_t *QB, *KB, *UB, *GSB, *GS5, *VT;
    __device__ __forceinline__ void operator()(const f32x4 (&acc)[2][2][4][2], const pg::GUnit& u, int wr, int wc, int fr, int fq) const {
        if (u.x0 == 0) {
            bf16_t* base; int ld, colt, mode; const int pn = u.pn; bool gm = false, km = false;
            if (pn < 2) { base = QB; ld = SBW; colt = pn * 256; mode = 1; }
            else if (pn < 4) { base = KB; ld = SBW; colt = (pn - 2) * 256; mode = 0; km = true; }
            else if (pn < 6) { base = UB; ld = S5H; colt = (pn - 4) * 256; mode = 0; gm = true; }
            else if (pn < 10) { base = GSB; ld = D; colt = (pn - 6) * 256; mode = 2; }
            else { base = GS5; ld = D; colt = (pn - 10) * 256; mode = 2; }
            const int row0 = u.pm * 256 + wr * 64 + fr, col0 = colt + wc * 32 + 8 * fq;
            const size_t coff = gm ? (size_t)(col0 >> 4) * T * S5H + (col0 & 15) : km ? (size_t)((col0 >> 6) * 2048 + ((col0 >> 4) & 3) * 512 + ((col0 >> 3) & 1) * 256) : (size_t)col0;
            const size_t bjstep = gm ? (size_t)8 * T * S5H : km ? (size_t)4096 : (size_t)128;
            float rsv[2][4];
#pragma unroll
            for (int ai = 0; ai < 2; ++ai)
#pragma unroll
                for (int m = 0; m < 4; ++m) rsv[ai][m] = rstd1[row0 + ai * 128 + m * 16];
#pragma unroll
            for (int ai = 0; ai < 2; ++ai)
#pragma unroll
                for (int m = 0; m < 4; ++m) { const int row = row0 + ai * 128 + m * 16; float rs = rsv[ai][m]; if (mode == 1) rs *= C2;
                    bf16_t* rowp = base + (km ? (size_t)(row >> 5) * 16384 + (size_t)(row & 31) * 8 : (size_t)row * ld) + coff;
#pragma unroll
                    for (int bj = 0; bj < 2; ++bj) { f32x4 v0 = acc[ai][bj][m][0] * (mode == 2 ? -LOG2E * rs : rs), v1 = acc[ai][bj][m][1] * (mode == 2 ? -LOG2E * rs : rs);
                        if (mode == 2) {
#pragma unroll
                            for (int j = 0; j < 4; ++j) { v0[j] = __builtin_amdgcn_rcpf(1.0f + __builtin_amdgcn_exp2f(v0[j])); v1[j] = __builtin_amdgcn_rcpf(1.0f + __builtin_amdgcn_exp2f(v1[j])); } }
                        u32x4 w; w.x = cvt_pk_bf16(v0[0], v0[1]); w.y = cvt_pk_bf16(v0[2], v0[3]); w.z = cvt_pk_bf16(v1[0], v1[1]); w.w = cvt_pk_bf16(v1[2], v1[3]);
                        *(u32x4*)(rowp + bj * bjstep) = w; } }
        } else {
            const int row0 = u.pm * 256 + wr * 64 + fr, col0 = u.pn * 256 + wc * 32 + 8 * fq;
            f32x4 rs[2][2];
#pragma unroll
            for (int bj = 0; bj < 2; ++bj) { rs[bj][0] = *(const f32x4*)(rstd1 + col0 + bj * 128); rs[bj][1] = *(const f32x4*)(rstd1 + col0 + bj * 128 + 4); }
#pragma unroll
            for (int ai = 0; ai < 2; ++ai)
#pragma unroll
                for (int m = 0; m < 4; ++m) { bf16_t* rowp = VT + (size_t)(row0 + ai * 128 + m * 16) * T + col0;
#pragma unroll
                    for (int bj = 0; bj < 2; ++bj) { const f32x4 v0 = acc[ai][bj][m][0] * rs[bj][0], v1 = acc[ai][bj][m][1] * rs[bj][1];
                        u32x4 w; w.x = cvt_pk_bf16(v0[0], v0[1]); w.y = cvt_pk_bf16(v0[2], v0[3]); w.z = cvt_pk_bf16(v1[0], v1[1]); w.w = cvt_pk_bf16(v1[2], v1[3]);
                        *(u32x4*)(rowp + bj * 128) = w; } }
        }
    }
};
namespace pg {
struct SrcS5 {
    static constexpr bool A_PER_UNIT = false;
    int ntA, nt2, KBl;
    __device__ __forceinline__ int nt() const { return ntA + nt2; }
    __device__ __forceinline__ const char* a_tile(const GUnit& u, int t) const { return t < ntA ? u.A + (size_t)t * 128 : u.A2 + (size_t)(t - ntA) * 128; }
    __device__ __forceinline__ const char* b_tile(const GUnit& u, int t) const { return u.B + (size_t)t * (BK * 2); }
    __device__ __forceinline__ unsigned a_off(const GUnit&, int R, int C) const { return (unsigned)(R * 512 + C * 2); }
    __device__ __forceinline__ unsigned b_off(int R, int C) const { return (unsigned)(R * KBl + C) * 2u; }
    __device__ __forceinline__ size_t b_hstep() const { return (size_t)HALF * KBl * 2; }
};
}
struct SchedS5 {
    int G, c; const char *UB, *SIN, *Bm; size_t bstride;
    __device__ __forceinline__ bool next(int i, pg::GUnit& u) const {
        const int L = c; if (i > 0 || L >= 128) return false;
        const int g = ((L & 7) << 2) | ((L >> 3) & 3)  , mt = L >> 5; u.pm = mt; u.pn = 0; u.x0 = g; u.x1 = 0; u.nvalid = 256; u.list = nullptr;
        u.A = UB + ((size_t)g * T * 32 + (size_t)mt * 256 * 512); u.A2 = SIN + ((size_t)g * NCHUNK + (size_t)mt * 256) * 512; u.B = Bm + (size_t)g * bstride; return true;
    }
};
struct EpiSloc {
    static constexpr bool PERM = false; float* SLOC;
    __device__ __forceinline__ void operator()(const f32x4 (&acc)[2][2][4][2], const pg::GUnit& u, int wr, int wc, int fr, int fq) const {
#pragma unroll
        for (int ai = 0; ai < 2; ++ai)
#pragma unroll
            for (int m = 0; m < 4; ++m) { const int chunk = u.pm * 256 + ai * 128 + wr * 64 + m * 16 + fr; float* rowp = SLOC + ((size_t)chunk * S5G + u.x0) * 128 + wc * 32 + 4 * fq;
#pragma unroll
                for (int n = 0; n < 2; ++n) *(f32x4*)(rowp + 16 * n) = acc[ai][0][m][n]; }
    }
};
struct EpiY {
    static constexpr bool PERM = true; bf16_t* Y2;
    __device__ __forceinline__ void operator()(const f32x4 (&acc)[2][2][4][2], const pg::GUnit& u, int wr, int wc, int fr, int fq) const {
#pragma unroll
        for (int ai = 0; ai < 2; ++ai)
#pragma unroll
            for (int m = 0; m < 4; ++m) { const int chunk = u.pm * 256 + ai * 128 + wr * 64 + m * 16 + fr;
#pragma unroll
                for (int bj = 0; bj < 2; ++bj) { const int c = bj * 128 + wc * 32 + 8 * fq, i = c >> 4, h0 = c & 15; const f32x4 v0 = acc[ai][bj][m][0], v1 = acc[ai][bj][m][1];
                    u32x4 w; w.x = cvt_pk_bf16(gelu_tanh(v0[0]), gelu_tanh(v0[1])); w.y = cvt_pk_bf16(gelu_tanh(v0[2]), gelu_tanh(v0[3])); w.z = cvt_pk_bf16(gelu_tanh(v1[0]), gelu_tanh(v1[1])); w.w = cvt_pk_bf16(gelu_tanh(v1[2]), gelu_tanh(v1[3]));
                    *(u32x4*)(Y2 + ((size_t)chunk * LC + i) * S5W + u.x0 * S5H + h0) = w; } }
    }
};
__device__ __forceinline__ void p3_scan(Frame& F) {
    if (F.bid >= NB * S5G) return;
    __builtin_amdgcn_fence(__ATOMIC_ACQUIRE, "workgroup"); asm volatile("s_waitcnt vmcnt(0)" ::: "memory");
    const int b = F.bid >> 5, g = ((F.bid & 7) << 2) | ((F.bid >> 3) & 3), p = F.lane, w = F.wave;
    float lr, li; cpow_lam(F.lam_re[g * S5P + p], F.lam_im[g * S5P + p], expf(F.log_step[g]), lr, li);
#pragma unroll
    for (int s = 0; s < 4; ++s) { const float nr = lr * lr - li * li, ni = 2.f * lr * li; lr = nr; li = ni; }
    const float* sl = F.SLOC + ((size_t)(b * 256 + 32 * w) * S5G + g) * 128 + p;
    float ar[32], ai[32];
#pragma unroll
    for (int j = 0; j < 32; ++j) { ar[j] = sl[(size_t)j * S5G * 128]; ai[j] = sl[(size_t)j * S5G * 128 + 64]; }
    float er = 0.f, ei = 0.f;
#pragma unroll
    for (int j = 0; j < 32; ++j) { const float nr = lr * er - li * ei + ar[j], ni = lr * ei + li * er + ai[j]; er = nr; ei = ni; }
    LAS float* es = (LAS float*)F.lds;
    es[(w * 2) * 64 + p] = er; es[(w * 2 + 1) * 64 + p] = ei;
    float br = lr, bi = li;
#pragma unroll
    for (int s = 0; s < 5; ++s) { const float nr = br * br - bi * bi, ni = 2.f * br * bi; br = nr; bi = ni; }
    __syncthreads();
    float sr = 0.f, si = 0.f;
    for (int w2 = 0; w2 < w; ++w2) { const float xr = es[(w2 * 2) * 64 + p], xi = es[(w2 * 2 + 1) * 64 + p]; const float nr = br * sr - bi * si + xr, ni = br * si + bi * sr + xi; sr = nr; si = ni; }
    bf16_t* so = F.SIN + ((size_t)g * NCHUNK + b * 256 + 32 * w) * 256;
#pragma unroll
    for (int j = 0; j < 32; ++j) { bf16_t* o = so + (size_t)j * 256;
        o[p] = f2bf(sr); o[64 + p] = f2bf(si);
        const float nr = lr * sr - li * si + ar[j], ni = lr * si + li * sr + ai[j]; sr = nr; si = ni; }
    asm volatile("s_waitcnt vmcnt(0)" ::: "memory");
    __syncthreads();
    __builtin_amdgcn_fence(__ATOMIC_ACQUIRE, "workgroup"); asm volatile("s_waitcnt vmcnt(0)" ::: "memory");
}
struct SchedTiles {
    int G, c, nM, nN, passes; const char *A0, *A1, *B0, *B1; size_t arow, brow;
    __device__ __forceinline__ bool next(int i, pg::GUnit& u) const {
        const int tile = c + (i / passes) * G, pass = i % passes, nwg = nM * nN; if (tile >= nwg) return false;
        int w = tile; if ((nwg & 7) == 0) w = (tile & 7) * (nwg >> 3) + (tile >> 3);
        const int nig = 8 * nN, gid = w / nig, rem = w % nig, fm = gid * 8, gsz = (nM - fm) < 8 ? (nM - fm) : 8;
        u.pm = fm + rem % gsz; u.pn = rem / gsz; u.x0 = pass; u.x1 = 0; u.nvalid = 256; u.list = nullptr; u.A2 = nullptr;
        u.A = (pass ? A1 : A0) + (size_t)u.pm * arow; u.B = (pass ? B1 : B0) + (size_t)u.pn * brow; return true;
    }
};
struct SchedOne {
    int pm, pn; const char* A; const char* B;
    __device__ __forceinline__ bool next(int i, pg::GUnit& u) const { if (i > 0) return false; u.pm = pm; u.pn = pn; u.x0 = 0; u.x1 = 0; u.nvalid = 256; u.list = nullptr; u.A2 = nullptr; u.A = A; u.B = B; return true; }
};
struct EpiGlu {
    static constexpr bool PERM = true; const bf16_t* Y2; bf16_t* YS5;
    __device__ __forceinline__ void operator()(const f32x4 (&acc)[2][2][4][2], const pg::GUnit& u, int wr, int wc, int fr, int fq) const {
#pragma unroll
        for (int ai = 0; ai < 2; ++ai) { u32x4 yv[4][2];
#pragma unroll
            for (int m = 0; m < 4; ++m)
#pragma unroll
                for (int bj = 0; bj < 2; ++bj) yv[m][bj] = *(const u32x4*)(Y2 + (size_t)(u.pm * 256 + ai * 128 + wr * 64 + m * 16 + fr) * S5W + u.pn * 256 + bj * 128 + wc * 32 + 8 * fq);
#pragma unroll
            for (int m = 0; m < 4; ++m)
#pragma unroll
                for (int bj = 0; bj < 2; ++bj) { const size_t off = (size_t)(u.pm * 256 + ai * 128 + wr * 64 + m * 16 + fr) * S5W + u.pn * 256 + bj * 128 + wc * 32 + 8 * fq; const u32x4 y = yv[m][bj]; const f32x4 v0 = acc[ai][bj][m][0], v1 = acc[ai][bj][m][1];
                    u32x4 w; w.x = cvt_pk_bf16(bflo(y.x) * fast_sigmoid(v0[0]), bfhi(y.x) * fast_sigmoid(v0[1])); w.y = cvt_pk_bf16(bflo(y.y) * fast_sigmoid(v0[2]), bfhi(y.y) * fast_sigmoid(v0[3]));
                    w.z = cvt_pk_bf16(bflo(y.z) * fast_sigmoid(v1[0]), bfhi(y.z) * fast_sigmoid(v1[1])); w.w = cvt_pk_bf16(bflo(y.w) * fast_sigmoid(v1[2]), bfhi(y.w) * fast_sigmoid(v1[3]));
                    *(u32x4*)(YS5 + off) = w; } }
    }
};
struct EpiMerge {
    static constexpr bool PERM = true; const bf16_t *GSB, *GS5; bf16_t* MRG;
    __device__ __forceinline__ void operator()(const f32x4 (&acc)[2][2][4][2], const pg::GUnit& u, int wr, int wc, int fr, int fq) const {
        const bf16_t* gate = u.x0 ? GS5 : GSB;
#pragma unroll
        for (int ai = 0; ai < 2; ++ai) { u32x4 gv[4][2], pv[4][2];
#pragma unroll
            for (int m = 0; m < 4; ++m)
#pragma unroll
                for (int bj = 0; bj < 2; ++bj) { const size_t off = (size_t)(u.pm * 256 + ai * 128 + wr * 64 + m * 16 + fr) * D + u.pn * 256 + bj * 128 + wc * 32 + 8 * fq; gv[m][bj] = *(const u32x4*)(gate + off); pv[m][bj] = u.x0 ? *(const u32x4*)(MRG + off) : (u32x4){0u, 0u, 0u, 0u}; }
#pragma unroll
            for (int m = 0; m < 4; ++m)
#pragma unroll
                for (int bj = 0; bj < 2; ++bj) { const size_t off = (size_t)(u.pm * 256 + ai * 128 + wr * 64 + m * 16 + fr) * D + u.pn * 256 + bj * 128 + wc * 32 + 8 * fq; const u32x4 gt = gv[m][bj], pp = pv[m][bj]; const f32x4 v0 = acc[ai][bj][m][0], v1 = acc[ai][bj][m][1];
                    const float o[8] = {bflo(gt.x) * v0[0] + bflo(pp.x), bfhi(gt.x) * v0[1] + bfhi(pp.x), bflo(gt.y) * v0[2] + bflo(pp.y), bfhi(gt.y) * v0[3] + bfhi(pp.y), bflo(gt.z) * v1[0] + bflo(pp.z), bfhi(gt.z) * v1[1] + bfhi(pp.z), bflo(gt.w) * v1[2] + bflo(pp.w), bfhi(gt.w) * v1[3] + bfhi(pp.w)};
                    u32x4 w; w.x = cvt_pk_bf16(o[0], o[1]); w.y = cvt_pk_bf16(o[2], o[3]); w.z = cvt_pk_bf16(o[4], o[5]); w.w = cvt_pk_bf16(o[6], o[7]);
                    *(u32x4*)(MRG + off) = w; } }
    }
};
struct EpiOut {
    static constexpr bool PERM = true; const bf16_t* x; bf16_t* X1; bf16_t* X1B; float* SS2P; const float* gffn;
    __device__ __forceinline__ void operator()(const f32x4 (&acc)[2][2][4][2], const pg::GUnit& u, int wr, int wc, int fr, int fq) const {
        float ss[2][4];
#pragma unroll
        for (int ai = 0; ai < 2; ++ai)
#pragma unroll
            for (int m = 0; m < 4; ++m) ss[ai][m] = 0.f;
#pragma unroll
        for (int bj = 0; bj < 2; ++bj) { const int col = u.pn * 256 + bj * 128 + wc * 32 + 8 * fq; const f32x4 g0 = *(const f32x4*)(gffn + col), g1 = *(const f32x4*)(gffn + col + 4);
#pragma unroll
            for (int ai = 0; ai < 2; ++ai) { u32x4 xv[4];
#pragma unroll
                for (int m = 0; m < 4; ++m) { const size_t off = (size_t)(u.pm * 256 + ai * 128 + wr * 64 + m * 16 + fr) * D + col; xv[m] = *(const u32x4*)(x + off); }
#pragma unroll
                for (int m = 0; m < 4; ++m) { const size_t off = (size_t)(u.pm * 256 + ai * 128 + wr * 64 + m * 16 + fr) * D + col;
                    const f32x4 o0 = (f32x4){bflo(xv[m].x), bfhi(xv[m].x), bflo(xv[m].y), bfhi(xv[m].y)} + acc[ai][bj][m][0], o1 = (f32x4){bflo(xv[m].z), bfhi(xv[m].z), bflo(xv[m].w), bfhi(xv[m].w)} + acc[ai][bj][m][1];
                    { u32x4 wb; wb.x = cvt_pk_bf16(o0[0], o0[1]); wb.y = cvt_pk_bf16(o0[2], o0[3]); wb.z = cvt_pk_bf16(o1[0], o1[1]); wb.w = cvt_pk_bf16(o1[2], o1[3]); *(u32x4*)(X1 + off) = wb; }
#if MOE_FP8
                    const f32x4 p0 = o0 * g0, p1 = o1 * g1; u32x2 w8; w8.x = pk4_fp8(p0[0], p0[1], p0[2], p0[3]); w8.y = pk4_fp8(p1[0], p1[1], p1[2], p1[3]); *(u32x2*)((unsigned char*)X1B + off) = w8;
#else
                    u32x4 w; w.x = cvt_pk_bf16(o0[0], o0[1]); w.y = cvt_pk_bf16(o0[2], o0[3]); w.z = cvt_pk_bf16(o1[0], o1[1]); w.w = cvt_pk_bf16(o1[2], o1[3]);
                    *(u32x4*)(X1B + off) = w;
#endif
                    ss[ai][m] += (o0[0] * o0[0] + o0[1] * o0[1]) + (o0[2] * o0[2] + o0[3] * o0[3]) + (o1[0] * o1[0] + o1[1] * o1[1]) + (o1[2] * o1[2] + o1[3] * o1[3]); } } }
#pragma unroll
        for (int ai = 0; ai < 2; ++ai)
#pragma unroll
            for (int m = 0; m < 4; ++m) { float s = ss[ai][m]; s += __shfl_xor(s, 16); s += __shfl_xor(s, 32);
                if (fq == 0) SS2P[(size_t)(u.pm * 256 + ai * 128 + wr * 64 + m * 16 + fr) * 16 + u.pn * 4 + wc] = s; }
    }
};
__device__ __forceinline__ int crow(int r, int hi) { return (r & 3) + 8 * (r >> 2) + 4 * hi; }
__device__ __forceinline__ void p8_router(Frame& F, unsigned* cntw, int* LISTp, float* GATELp, float* RS2Lp) {
    const int lane = F.lane, r32 = lane & 31, hi = lane >> 5, rg = F.wave >> 2, kq = F.wave & 3;
    LAS float* part = (LAS float*)F.lds;
    LAS unsigned* wl = (LAS unsigned*)(F.lds + 32768 + F.wave * 256);
    for (int bu0 = F.bid; bu0 < T / 64; bu0 += F.G) {
        const int bu = (F.G == 256) ? (((F.bid & 7) * 8 + (F.bid >> 5)) * 4 + ((F.bid >> 3) & 3)) : bu0;
        const int row = bu * 64 + rg * 32 + r32;
        const bf16_t* xr = F.X1BF + (size_t)row * D + kq * 256 + 8 * hi;
        const bf16_t* wh = F.WR + (size_t)(kq * 16) * 512 + hi * 256 + r32 * 8; const bf16_t* wlo = wh + NE * D;
        f32x16 acc = {};
#pragma unroll 8
        for (int s = 0; s < 16; ++s) {
            const bf16x8 bh = *(const bf16x8*)(xr + 16 * s);
            const bf16x8 ah = *(const bf16x8*)(wh + 512 * s), al = *(const bf16x8*)(wlo + 512 * s);
            acc = __builtin_amdgcn_mfma_f32_32x32x16_bf16(ah, bh, acc, 0, 0, 0);
            acc = __builtin_amdgcn_mfma_f32_32x32x16_bf16(al, bh, acc, 0, 0, 0);
        }
#pragma unroll
        for (int i = 0; i < 16; ++i) part[(F.wave * 16 + i) * 64 + lane] = acc[i];
        __syncthreads();
        if (kq == 0) {
#pragma unroll
            for (int i = 0; i < 16; ++i) acc[i] = ((part[((F.wave + 0) * 16 + i) * 64 + lane] + part[((F.wave + 1) * 16 + i) * 64 + lane]) + part[((F.wave + 2) * 16 + i) * 64 + lane]) + part[((F.wave + 3) * 16 + i) * 64 + lane];
            float ss = 0.f;
#pragma unroll
            for (int j = 0; j < 4; ++j) { const f32x4 p = *(const f32x4*)(F.SS2P + (size_t)row * 16 + 4 * j); ss += (p[0] + p[1]) + (p[2] + p[3]); }
            const float rs = rsqrtf(ss * (1.0f / D) + RMS_EPS);
            if (hi == 0) F.RSTD2[row] = rs;
            float lg[NE];
#pragma unroll
            for (int i = 0; i < 16; ++i) { const float own = acc[i], oth = __shfl_xor(own, 32); const float v0 = hi ? oth : own, v1 = hi ? own : oth;
                lg[crow(i, 0)] = rs * v0 + F.b_router[crow(i, 0)]; lg[crow(i, 1)] = rs * v1 + F.b_router[crow(i, 1)]; }
            int idx[TOPK]; float val[TOPK];
#pragma unroll
            for (int k = 0; k < TOPK; ++k) { float best = -INFINITY; int bi = 0;
#pragma unroll
                for (int e = 0; e < NE; ++e) { bool taken = false;
#pragma unroll
                    for (int kk = 0; kk < k; ++kk) taken |= (idx[kk] == e);
                    if (!taken && lg[e] > best) { best = lg[e]; bi = e; } }
                idx[k] = bi; val[k] = best; }
            float w[TOPK], sum = 0.f;
#pragma unroll
            for (int k = 0; k < TOPK; ++k) { w[k] = __expf(val[k] - val[0]); sum += w[k]; }
            const float inv = 1.0f / sum;
            if (lane < 32) wl[lane] = 0u;
            asm volatile("s_waitcnt lgkmcnt(0)" ::: "memory");
            unsigned rank[TOPK];
#pragma unroll
            for (int k = 0; k < TOPK; ++k) rank[k] = (hi == 0) ? __hip_atomic_fetch_add((LAS unsigned*)wl + idx[k], 1u, __ATOMIC_RELAXED, __HIP_MEMORY_SCOPE_WORKGROUP) : 0u;
            asm volatile("s_waitcnt lgkmcnt(0)" ::: "memory");
            if (lane < 32) { const unsigned c = wl[lane]; unsigned base = 0u; if (c) base = atomicAdd(cntw + 64 * lane, c); wl[32 + lane] = base; }
            asm volatile("s_waitcnt vmcnt(0) lgkmcnt(0)" ::: "memory");
            if (hi == 0) {
#pragma unroll
                for (int k = 0; k < TOPK; ++k) { const unsigned pos = wl[32 + idx[k]] + rank[k]; LISTp[(size_t)idx[k] * T + pos] = row * 4 + k; GATELp[(size_t)idx[k] * T + pos] = w[k] * inv; RS2Lp[(size_t)idx[k] * T + pos] = rs; }
            }
            asm volatile("s_waitcnt lgkmcnt(0)" ::: "memory");
        }
        __syncthreads();
    }
}
__device__ __forceinline__ void moe_prefix(Frame& F) {
    if (F.tid < NE) F.MISC[64 + F.tid] = __hip_atomic_load(F.ctl + CW_CNT + 64 * F.tid, __ATOMIC_RELAXED, __HIP_MEMORY_SCOPE_AGENT);
    __syncthreads();
    if (F.tid == 0) { int accp = 0; for (int e = 0; e < NE; ++e) { F.MISC[16 + e] = (unsigned)accp; accp += (int)((F.MISC[64 + e] + 255u) >> 8); } F.MISC[16 + NE] = (unsigned)accp; }
    __syncthreads();
}
struct SchedMoe {
    int sb_off, rt_hi, single;
    int G, c, nper, tpre, tcnt; const int* LIST; const float* FMETA; const char* Abase; const char* Bbase; size_t bexp, atile, btile; bool gather; const float* BIAS;
    __device__ __forceinline__ void load_tables(const LAS unsigned* pre, int lane) { tpre = (int)pre[lane < 33 ? lane : 32]; tcnt = (int)pre[48 + (lane & 31)]; }
    __device__ __forceinline__ int total_rt() const { return __builtin_amdgcn_readlane(tpre, NE); }
    __device__ __forceinline__ bool next(int i, pg::GUnit& u) const {
        int rt, nt;
        if (single && i > 0) return false;
        if ((G & 255) == 0) { const int cc = c & 255, x = cc & 7, s = cc >> 3, rpb = 32 / nper, sb = sb_off + (i * (G >> 8) + (c >> 8)) * 8 + x; rt = sb * rpb + s / nper; nt = s % nper; }
        else { const int L = i * G + c; rt = L / nper; nt = L % nper; }
        if (rt >= rt_hi) return false;
        int e = 0, hi_ = NE - 1;
#pragma unroll
        for (int it = 0; it < 5; ++it) { const int mid = (e + hi_ + 1) >> 1; const int pm_ = __builtin_amdgcn_readlane(tpre, mid); if (pm_ <= rt) e = mid; else hi_ = mid - 1; }
        const int pe = __builtin_amdgcn_readlane(tpre, e);
        const int mt = rt - pe, cnt = __builtin_amdgcn_readlane(tcnt, e);
        u.x0 = e; u.x1 = rt * 256; u.pm = mt; u.pn = nt; u.nvalid = (cnt - mt * 256) < 256 ? (cnt - mt * 256) : 256; u.list = LIST + (size_t)e * T + mt * 256; u.A2 = (const char*)(FMETA + (size_t)e * T + mt * 256);
        u.A = gather ? Abase : Abase + (size_t)rt * atile; u.B = Bbase + (size_t)e * bexp + (size_t)nt * btile;
        if (gather) { u.bias = BIAS + (size_t)e * 2 * DFF + 128 * nt; u.bstep = DFF; } else { u.bias = BIAS + (size_t)e * D + 256 * nt; u.bstep = 128; }
        return true;
    }
};
struct EpiUp {
    static constexpr bool PERM = true; const float *RSTD2, *b_up; bf16_t* ACT;
    __device__ __forceinline__ void operator()(const f32x4 (&acc)[2][2][4][2], const pg::GUnit& u, int wr, int wc, int fr, int fq) const {
        const int j0 = 128 * u.pn + 32 * wc + 8 * fq; const float* bu = b_up + (size_t)u.x0 * 2 * DFF + j0;
        const f32x4 bg0 = *(const f32x4*)bu, bg1 = *(const f32x4*)(bu + 4), bl0 = *(const f32x4*)(bu + DFF), bl1 = *(const f32x4*)(bu + DFF + 4);
        float rsv[2][4]; const float* rl = RSTD2 + (size_t)u.x0 * T + u.pm * 256;
#pragma unroll
        for (int ai = 0; ai < 2; ++ai)
#pragma unroll
            for (int m = 0; m < 4; ++m) { const int r = ai * 128 + wr * 64 + m * 16 + fr; rsv[ai][m] = rl[r < u.nvalid ? r : 0]; }
#pragma unroll
        for (int ai = 0; ai < 2; ++ai)
#pragma unroll
            for (int m = 0; m < 4; ++m) { const int r = ai * 128 + wr * 64 + m * 16 + fr; if (r < u.nvalid) { const float rs = rsv[ai][m];
                const f32x4 g0 = acc[ai][0][m][0] * rs + bg0, g1 = acc[ai][0][m][1] * rs + bg1, l0 = acc[ai][1][m][0] * rs + bl0, l1 = acc[ai][1][m][1] * rs + bl1; float o[8];
#pragma unroll
                for (int q = 0; q < 4; ++q) { const float ga = fminf(g0[q], LIMIT), gb = fminf(g1[q], LIMIT), la = fminf(fmaxf(l0[q], -LIMIT), LIMIT), lb = fminf(fmaxf(l1[q], -LIMIT), LIMIT);
                    o[q] = ga * fast_sigmoid(ALPHA * ga) * (la + 1.0f); o[4 + q] = gb * fast_sigmoid(ALPHA * gb) * (lb + 1.0f); }
#if MOE_FP8
                u32x2 w8; w8.x = pk4_fp8(o[0], o[1], o[2], o[3]); w8.y = pk4_fp8(o[4], o[5], o[6], o[7]); *(u32x2*)((unsigned char*)ACT + (size_t)(u.x1 + r) * DFF + j0) = w8; } }
#else
                u32x4 w; w.x = cvt_pk_bf16(o[0], o[1]); w.y = cvt_pk_bf16(o[2], o[3]); w.z = cvt_pk_bf16(o[4], o[5]); w.w = cvt_pk_bf16(o[6], o[7]);
                *(u32x4*)(ACT + (size_t)(u.x1 + r) * DFF + j0) = w; } }
#endif
    }
};
struct EpiDown {
    static constexpr bool PERM = true; const float *GATEL, *b_down; bf16_t* YSLOT;
    __device__ __forceinline__ void operator()(const f32x4 (&acc)[2][2][4][2], const pg::GUnit& u, int wr, int wc, int fr, int fq) const {
        const int c0 = 256 * u.pn + 32 * wc + 8 * fq; const float* bd = b_down + (size_t)u.x0 * D + c0;
        f32x4 bv[2][2];
#pragma unroll
        for (int bj = 0; bj < 2; ++bj) { bv[bj][0] = *(const f32x4*)(bd + bj * 128); bv[bj][1] = *(const f32x4*)(bd + bj * 128 + 4); }
        const float* gl = GATEL + (size_t)u.x0 * T + u.pm * 256;
        int slv[2][4]; float gtv[2][4];
#pragma unroll
        for (int ai = 0; ai < 2; ++ai)
#pragma unroll
            for (int m = 0; m < 4; ++m) { const int r = ai * 128 + wr * 64 + m * 16 + fr, rr = r < u.nvalid ? r : 0; slv[ai][m] = u.list[rr]; gtv[ai][m] = gl[rr]; }
#pragma unroll
        for (int ai = 0; ai < 2; ++ai)
#pragma unroll
            for (int m = 0; m < 4; ++m) { const int r = ai * 128 + wr * 64 + m * 16 + fr; if (r < u.nvalid) { const float gt = gtv[ai][m]; bf16_t* rowp = YSLOT + (size_t)slv[ai][m] * D + c0;
#pragma unroll
                for (int bj = 0; bj < 2; ++bj) { const f32x4 v0 = (acc[ai][bj][m][0] + bv[bj][0]) * gt, v1 = (acc[ai][bj][m][1] + bv[bj][1]) * gt;
#if MOE_FP8
                    u32x2 w8; w8.x = pk4_fp8(v0[0] * 16.f, v0[1] * 16.f, v0[2] * 16.f, v0[3] * 16.f); w8.y = pk4_fp8(v1[0] * 16.f, v1[1] * 16.f, v1[2] * 16.f, v1[3] * 16.f);
                    *(u32x2*)((unsigned char*)YSLOT + (size_t)slv[ai][m] * D + c0 + bj * 128) = w8; } } }
#else
                    u32x4 w; w.x = cvt_pk_bf16(v0[0], v0[1]); w.y = cvt_pk_bf16(v0[2], v0[3]); w.z = cvt_pk_bf16(v1[0], v1[1]); w.w = cvt_pk_bf16(v1[2], v1[3]);
                    *(u32x4*)(rowp + bj * 128) = w; } } }
#endif
    }
};
struct EpiUpM {
    static constexpr bool PERM = true; const float* b_up; bf16_t* ACT;
    __device__ __forceinline__ void operator()(const f32x4 (&acc)[2][2][4][2], const pg::GUnit& u, int wr, int wc, int fr, int fq, LAS unsigned char* ms) const {
        const int j0 = 128 * u.pn + 32 * wc + 8 * fq; const LAS float* bs = (const LAS float*)(ms + 2048) + 32 * wc + 8 * fq;
        const f32x4 bg0 = *(const LAS f32x4*)bs, bg1 = *(const LAS f32x4*)(bs + 4), bl0 = *(const LAS f32x4*)(bs + 128), bl1 = *(const LAS f32x4*)(bs + 132);
        const LAS float* rl = (const LAS float*)(ms + 1024);
#pragma unroll
        for (int ai = 0; ai < 2; ++ai)
#pragma unroll
            for (int m = 0; m < 4; ++m) { const int r = ai * 128 + wr * 64 + m * 16 + fr; if (r < u.nvalid) { const float rs = rl[r];
                const f32x4 g0 = acc[ai][0][m][0] * rs + bg0, g1 = acc[ai][0][m][1] * rs + bg1, l0 = acc[ai][1][m][0] * rs + bl0, l1 = acc[ai][1][m][1] * rs + bl1; float o[8];
#pragma unroll
                for (int q = 0; q < 4; ++q) { const float ga = fminf(g0[q], LIMIT), gb = fminf(g1[q], LIMIT), la = fminf(fmaxf(l0[q], -LIMIT), LIMIT), lb = fminf(fmaxf(l1[q], -LIMIT), LIMIT);
                    const float sa = ga * __builtin_amdgcn_rcpf(1.0f + __builtin_amdgcn_exp2f((-ALPHA * LOG2E) * ga)), sb = gb * __builtin_amdgcn_rcpf(1.0f + __builtin_amdgcn_exp2f((-ALPHA * LOG2E) * gb));
                    o[q] = __builtin_fmaf(sa, la, sa); o[4 + q] = __builtin_fmaf(sb, lb, sb); }
                u32x2 w8; w8.x = pk4_fp8_nc(o[0], o[1], o[2], o[3]); w8.y = pk4_fp8_nc(o[4], o[5], o[6], o[7]);
                *(u32x2*)((unsigned char*)ACT + (size_t)(u.x1 + r) * DFF + j0) = w8; } }
    }
};
struct EpiDownM {
    static constexpr bool PERM = true; const float* b_down; bf16_t* YSLOT;
    __device__ __forceinline__ void operator()(const f32x4 (&acc)[2][2][4][2], const pg::GUnit& u, int wr, int wc, int fr, int fq, LAS unsigned char* ms) const {
        const int c0 = 256 * u.pn + 32 * wc + 8 * fq; const LAS float* bs = (const LAS float*)(ms + 2048) + 32 * wc + 8 * fq;
        f32x4 bv[2][2];
#pragma unroll
        for (int bj = 0; bj < 2; ++bj) { bv[bj][0] = *(const LAS f32x4*)(bs + bj * 128); bv[bj][1] = *(const LAS f32x4*)(bs + bj * 128 + 4); }
        const LAS int* sl = (const LAS int*)ms; const LAS float* gl = (const LAS float*)(ms + 1024);
#pragma unroll
        for (int ai = 0; ai < 2; ++ai)
#pragma unroll
            for (int m = 0; m < 4; ++m) { const int r = ai * 128 + wr * 64 + m * 16 + fr; if (r < u.nvalid) { const float gt = gl[r] * 16.f; unsigned char* rowp = (unsigned char*)YSLOT + (size_t)sl[r] * D + c0;
#pragma unroll
                for (int bj = 0; bj < 2; ++bj) { const f32x4 v0 = (acc[ai][bj][m][0] + bv[bj][0]) * gt, v1 = (acc[ai][bj][m][1] + bv[bj][1]) * gt;
                    u32x2 w8; w8.x = pk4_fp8(v0[0], v0[1], v0[2], v0[3]); w8.y = pk4_fp8(v1[0], v1[1], v1[2], v1[3]);
                    *(u32x2*)(rowp + bj * 128) = w8; } } }
    }
};
__device__ __forceinline__ void p11_row_load(const Frame& F, int m, f32x4 (&v)[4], unsigned (&y)[4][TOPK], int lane) {
    const u32x2* xr = (const u32x2*)(F.X1BF + (size_t)m * D) + lane;
#pragma unroll
    for (int j = 0; j < 4; ++j) { const u32x2 xb = xr[64 * j]; v[j] = (f32x4){bflo(xb.x), bfhi(xb.x), bflo(xb.y), bfhi(xb.y)};
#pragma unroll
        for (int k = 0; k < TOPK; ++k) {
#if MOE_FP8
            y[j][k] = __builtin_nontemporal_load((const unsigned*)((const unsigned char*)F.YSLOT + ((size_t)m * 4 + k) * D) + lane + 64 * j);
#else
            y[j][k] = 0u;
#endif
        } }
}
__device__ __forceinline__ void p11_row_finish(const Frame& F, int m, f32x4 (&v)[4], const unsigned (&y)[4][TOPK], float* outp, int lane) {
    float s = 0.f;
#pragma unroll
    for (int j = 0; j < 4; ++j) {
#pragma unroll
        for (int k = 0; k < TOPK; ++k) {
#if MOE_FP8
            const f32x2 lo = __builtin_amdgcn_cvt_pk_f32_fp8((int)y[j][k], false), hi2 = __builtin_amdgcn_cvt_pk_f32_fp8((int)y[j][k], true); v[j][0] += lo[0] * 0.0625f; v[j][1] += lo[1] * 0.0625f; v[j][2] += hi2[0] * 0.0625f; v[j][3] += hi2[1] * 0.0625f;
#else
            const u32x2 yy = *((const u32x2*)(F.YSLOT + ((size_t)m * 4 + k) * D) + lane + 64 * j); v[j][0] += bflo(yy.x); v[j][1] += bfhi(yy.x); v[j][2] += bflo(yy.y); v[j][3] += bfhi(yy.y);
#endif
        }
        s += (v[j][0] * v[j][0] + v[j][1] * v[j][1]) + (v[j][2] * v[j][2] + v[j][3] * v[j][3]); }
    s = wave_sum(s); const float r = rsqrtf(s * (1.0f / D) + RMS_EPS);
    f32x4* orow = (f32x4*)(outp + (size_t)m * D) + lane;
#pragma unroll
    for (int j = 0; j < 4; ++j) { const f32x4 g = *((const f32x4*)F.norm_final + lane + 64 * j); orow[64 * j] = v[j] * r * g; }
}
__device__ __forceinline__ void p11_final(Frame& F, float* outp) {
    const int gw = F.bid * NWAVES + F.wave, NGW = F.G * NWAVES, lane = F.lane;
    for (int m = gw; m < T; m += 2 * NGW) {
        const int m2 = m + NGW; f32x4 va[4], vb[4]; unsigned ya[4][TOPK], yb[4][TOPK];
        p11_row_load(F, m, va, ya, lane); if (m2 < T) p11_row_load(F, m2, vb, yb, lane);
        p11_row_finish(F, m, va, ya, outp, lane); if (m2 < T) p11_row_finish(F, m2, vb, yb, outp, lane);
    }
}
#ifndef ATTN_EARLY
#define ATTN_EARLY 1
#endif
constexpr float ATTN_THR = 152.0f;
__device__ __forceinline__ bf16x8 pack8(float a0, float a1, float a2, float a3, float a4, float a5, float a6, float a7) {
    return __builtin_bit_cast(bf16x8, (u32x4){cvt_pk_bf16(a0, a1), cvt_pk_bf16(a2, a3), cvt_pk_bf16(a4, a5), cvt_pk_bf16(a6, a7)});
}
template <bool DIAG>
__device__ __forceinline__ void attn_block(const f32x16& sv, float& R, const bf16x8 (&tri)[2], bf16x8 (&wb)[2], int keyb, int tq, int r32, int hi) {
    float sp[16];
#pragma unroll
    for (int i = 0; i < 16; ++i) { const float z = sv[i]; const float l = __builtin_amdgcn_logf(1.0f + __builtin_amdgcn_exp2f(-__builtin_fabsf(z)));
        float v = __builtin_amdgcn_fmed3f(z, 0.f, __builtin_fabsf(z))   + l; if (DIAG) v = (keyb + crow(i, hi) < tq) ? v : 0.f; sp[i] = v; }
    const bf16x8 b0 = pack8(sp[0], sp[1], sp[2], sp[3], sp[4], sp[5], sp[6], sp[7]), b1 = pack8(sp[8], sp[9], sp[10], sp[11], sp[12], sp[13], sp[14], sp[15]);
    f32x16 c;
#pragma unroll
    for (int i = 0; i < 16; ++i) c[i] = R;
    c = __builtin_amdgcn_mfma_f32_32x32x16_bf16(tri[0], b0, c, 0, 0, 0);
    c = __builtin_amdgcn_mfma_f32_32x32x16_bf16(tri[1], b1, c, 0, 0, 0);
    float w[16];
#pragma unroll
    for (int i = 0; i < 16; ++i) { float v = __builtin_amdgcn_exp2f(sv[i] - c[i]); if (DIAG) v = (keyb + crow(i, hi) < tq) ? v : 0.f; w[i] = v; }
    wb[0] = pack8(w[0], w[1], w[2], w[3], w[4], w[5], w[6], w[7]); wb[1] = pack8(w[8], w[9], w[10], w[11], w[12], w[13], w[14], w[15]);
    R = __shfl(c[0], r32);
}
__device__ __forceinline__ void attn_load_k(const Frame& F, bf16x8 (&kf)[2][4], int tokbase, int k0, int h, int r32, int hi) {
    const bf16_t* kp = F.KB + ((size_t)((tokbase + k0) >> 5) * 8 + h) * 2048 + hi * 256 + r32 * 8;
#pragma unroll
    for (int mt = 0; mt < 2; ++mt)
#pragma unroll
        for (int d0 = 0; d0 < 4; ++d0) kf[mt][d0] = *(const bf16x8*)(kp + (size_t)mt * 16384 + 512 * d0);
}
__device__ __forceinline__ void attn_unit(Frame& F, int b, int h, int qb, const bf16x8 (&tri)[2]) {
    const int lane = F.lane, r32 = lane & 31, hi = lane >> 5, tokbase = b * SEQ, q0 = qb * 32, tq = q0 + r32;
    const bf16_t* qp = F.QB + (size_t)(tokbase + tq) * SBW + h * HD + 8 * hi;
    bf16x8 qf[4];
#pragma unroll
    for (int d0 = 0; d0 < 4; ++d0) qf[d0] = *(const bf16x8*)(qp + 16 * d0);
    f32x16 o0 = {}, o1 = {}; float R = 0.f;
    bf16x8 kf[2][4], kn[2][4];
    attn_load_k(F, kf, tokbase, (qb >> 1) * 64, h, r32, hi);
    for (int kt = qb >> 1; kt >= 0; --kt) {
        const int k0 = kt * 64;
        const bf16_t* vp = F.VT + (size_t)(h * HD + r32) * T + tokbase + k0 + 8 * hi;
        u32x4 vv[2][2][2];
#pragma unroll
        for (int dm = 0; dm < 2; ++dm)
#pragma unroll
            for (int mt = 0; mt < 2; ++mt)
#pragma unroll
                for (int s = 0; s < 2; ++s) vv[dm][mt][s] = *(const u32x4*)(vp + (size_t)dm * 32 * T + 32 * mt + 16 * s);
        attn_load_k(F, kn, tokbase, kt > 0 ? k0 - 64 : k0, h, r32, hi);
        f32x16 s0 = {}, s1 = {};
#pragma unroll
        for (int d0 = 0; d0 < 4; ++d0) { s0 = __builtin_amdgcn_mfma_f32_32x32x16_bf16(kf[0][d0], qf[d0], s0, 0, 0, 0); s1 = __builtin_amdgcn_mfma_f32_32x32x16_bf16(kf[1][d0], qf[d0], s1, 0, 0, 0); }
        bf16x8 wb[2][2];
        if (kt == (qb >> 1)) { attn_block<true>(s1, R, tri, wb[1], k0 + 32, tq, r32, hi); attn_block<true>(s0, R, tri, wb[0], k0, tq, r32, hi); }
        else { attn_block<false>(s1, R, tri, wb[1], k0 + 32, tq, r32, hi); attn_block<false>(s0, R, tri, wb[0], k0, tq, r32, hi); }
#pragma unroll
        for (int mt = 0; mt < 2; ++mt)
#pragma unroll
            for (int s = 0; s < 2; ++s) { u32x4 q0 = vv[0][mt][s], q1 = vv[1][mt][s];
                { const auto a0 = __builtin_amdgcn_permlane32_swap(q0.x, q0.z, false, false), a1 = __builtin_amdgcn_permlane32_swap(q0.y, q0.w, false, false); q0 = (u32x4){a0[0], a1[0], a0[1], a1[1]}; }
                { const auto a0 = __builtin_amdgcn_permlane32_swap(q1.x, q1.z, false, false), a1 = __builtin_amdgcn_permlane32_swap(q1.y, q1.w, false, false); q1 = (u32x4){a0[0], a1[0], a0[1], a1[1]}; }
                const bf16x8 v0 = __builtin_bit_cast(bf16x8, q0), v1 = __builtin_bit_cast(bf16x8, q1);
                o0 = __builtin_amdgcn_mfma_f32_32x32x16_bf16(v0, wb[mt][s], o0, 0, 0, 0); o1 = __builtin_amdgcn_mfma_f32_32x32x16_bf16(v1, wb[mt][s], o1, 0, 0, 0); }
        if (ATTN_EARLY) { if (__all(R > ATTN_THR)) break; }
#pragma unroll
        for (int mt = 0; mt < 2; ++mt)
#pragma unroll
            for (int d0 = 0; d0 < 4; ++d0) kf[mt][d0] = kn[mt][d0];
    }
    bf16_t* op = F.YSB + (size_t)(tokbase + tq) * SBW + h * HD + 4 * hi;
#pragma unroll
    for (int g = 0; g < 4; ++g) { u32x2 a, c2; a.x = cvt_pk_bf16(o0[4 * g], o0[4 * g + 1]); a.y = cvt_pk_bf16(o0[4 * g + 2], o0[4 * g + 3]); c2.x = cvt_pk_bf16(o1[4 * g], o1[4 * g + 1]); c2.y = cvt_pk_bf16(o1[4 * g + 2], o1[4 * g + 3]);
        *(u32x2*)(op + 8 * g) = a; *(u32x2*)(op + 32 + 8 * g) = c2; }
}
__device__ __forceinline__ void attn_phase(Frame& F, int part) {
    const int lane = F.lane, r32 = lane & 31, hi = lane >> 5;
    bf16x8 tri[2];
#pragma unroll
    for (int s = 0; s < 2; ++s)
#pragma unroll
        for (int j = 0; j < 8; ++j) tri[s][j] = (16 * s + 8 * (j >> 2) + 4 * hi + (j & 3) >= r32) ? (short)0x3F80 : (short)0;
    constexpr int NU = NB * NH * 128;
    if (F.G == 256) {
        const int a0 = F.bid & 127, ap = ((a0 & 7) << 4) | (a0 >> 3);
        if (F.bid < 128) { const int W = ap * 8 + F.wave;
            if (part) attn_unit(F, W >> 8, (W >> 5) & 7, 96 + (W & 31), tri);
 }
        else if (part == 0) { const int W = ap * 8 + F.wave, b = W >> 8, h = (W >> 5) & 7, q = W & 31; attn_unit(F, b, h, 32 + q, tri); attn_unit(F, b, h, 64 + q, tri);
            { const int idx = ap * 4 + (F.wave & 3); attn_unit(F, idx >> 7, (idx >> 4) & 7, (F.wave < 4 ? 16 : 0) + (idx & 15), tri); } }
    } else if (part == 0) for (int u = F.bid * NWAVES + F.wave; u < NU; u += F.G * NWAVES) attn_unit(F, u >> 10, (u >> 7) & 7, u & 127, tri);
}
struct Args { const float* in[23]; float* out; unsigned char* ws; int ph_lo, ph_hi, li, pad; };
constexpr int N_PHASES = 12;
__global__ void __launch_bounds__(NWAVES * 64, 2) mk(Args args) {
    extern __shared__ __attribute__((aligned(16))) unsigned char lds[];
    Frame F;
    F.lds = (LAS unsigned char*)lds; F.MISC = (volatile LAS unsigned*)(F.lds + MISC_OFF);
    F.tid = threadIdx.x; F.lane = F.tid & 63; F.wave = __builtin_amdgcn_readfirstlane(F.tid >> 6); F.G = gridDim.x; F.bid = blockIdx.x;
    unsigned char* ws = args.ws; F.ws = ws; F.out = args.out; F.ctl = (unsigned*)(ws + WS_CTL);
    F.x = args.in[0]; F.norm_mix = args.in[1]; F.w_in = args.in[2]; F.lam_re = args.in[3]; F.lam_im = args.in[4]; F.b_re = args.in[5]; F.b_im = args.in[6]; F.c_re = args.in[7]; F.c_im = args.in[8];
    F.s5d = args.in[9]; F.log_step = args.in[10]; F.w_glu = args.in[11]; F.w_bsb = args.in[12]; F.w_bs5 = args.in[13]; F.w_out = args.in[14]; F.norm_ffn = args.in[15]; F.w_router = args.in[16];
    F.b_router = args.in[17]; F.w_up = args.in[18]; F.b_up = args.in[19]; F.w_down = args.in[20]; F.b_down = args.in[21]; F.norm_final = args.in[22];
    F.RSTD1 = (float*)(ws + WS_RSTD1); F.RSTD2 = (float*)(ws + WS_RSTD2); F.RB = (int*)(ws + WS_RB); F.LIST = (int*)(ws + WS_LIST); F.GATEL = (float*)(ws + WS_GATEL); F.SS2P = (float*)(ws + WS_SS2P);
    F.WR = (bf16_t*)(ws + WS_WR); F.XB = (bf16_t*)(ws + WS_XB); F.QB = (bf16_t*)(ws + WS_QB); F.KB = (bf16_t*)(ws + WS_KB); F.VT = (bf16_t*)(ws + WS_VT); F.UB = (bf16_t*)(ws + WS_UB);
    F.GSB = (bf16_t*)(ws + WS_GSB); F.GS5 = (bf16_t*)(ws + WS_GS5); F.YSB = (bf16_t*)(ws + WS_YSB); F.Y2 = (bf16_t*)(ws + WS_Y2); F.YS5 = (bf16_t*)(ws + WS_YS5); F.MRG = (bf16_t*)(ws + WS_MRG);
    F.X1B = (bf16_t*)(ws + WS_X1B); F.X1BF = (bf16_t*)(ws + WS_X1BF); F.ACT = (bf16_t*)(ws + WS_ACT); F.YSLOT = (bf16_t*)(ws + WS_YSLOT); F.WIN = (bf16_t*)(ws + WS_WIN); F.WGLU = (bf16_t*)(ws + WS_WGLU); F.WBSB = (bf16_t*)(ws + WS_WBSB);
    F.WBS5 = (bf16_t*)(ws + WS_WBS5); F.WOUT = (bf16_t*)(ws + WS_WOUT); F.M1T = (bf16_t*)(ws + WS_M1T); F.YT = (bf16_t*)(ws + WS_YT); F.SLOC = (float*)(ws + WS_SLOC); F.SIN = (bf16_t*)(ws + WS_SIN);
    F.WUP = (bf16_t*)(ws + WS_WUP); F.WDN = (bf16_t*)(ws + WS_WDN);
    for (int u = F.tid; u < (LDS_BYTES - RING_BYTES) / 4; u += NWAVES * 64) ((LAS unsigned*)(F.lds + RING_BYTES))[u] = 0u;
    __syncthreads();
    const int lo = args.ph_lo, hi = args.ph_hi;
    XcdBarrier bar; bar.bar = (unsigned*)(F.ctl + CW_BAR) + args.li * XCD_BAR_WORDS; bar.x = 0; bar.st = nullptr;
    if (hi - lo > 1) bar = xcd_barrier_post((unsigned*)(F.ctl + CW_BAR) + args.li * XCD_BAR_WORDS, F.MISC + 8);
#define IN(k) (lo <= (k) && (k) < hi)
#define NEXT_PH(k) ((k) == 2 ? 5 : (k) + 1)
#define BOTH(k) (IN(k) && IN(NEXT_PH(k)))
    if (IN(0)) { if (F.tid == 0 && bar.x != (unsigned)(F.bid & 7)) (void)xb_add(F.ctl + CW_PLACE, 1u);
        p0_prologue(F); __syncthreads(); cvt_expert_dyn(F, F.ctl + CW_QCVT); if (BOTH(0)) xcd_barrier(bar); }
    const bool local_ok = (hi - lo == N_PHASES) && F.G == 256 && __builtin_amdgcn_readfirstlane((int)xb_ld(F.ctl + CW_PLACE)) == 0;
    if (IN(1)) {
        pg::SrcPlain G{D}; SchedP1 S{F.G, F.bid, (const char*)F.XB, (const char*)F.WIN, 0, 1 << 20}; EpiInProj E{F.RSTD1, F.QB, F.KB, F.UB, F.GSB, F.GS5, F.VT};
        pg::gemm_phase(F.lds, G, S, E);
        if (BOTH(1)) xcd_barrier(bar);
    }
    if (IN(2)) {
        const bool fuse_glu = (F.G == 256);
        if (F.bid < NB * S5G) {
            { pg::SrcS5 G{4, 0, 256}; SchedS5 S{F.G, F.bid, (const char*)F.UB, (const char*)F.SIN, (const char*)F.M1T, (size_t)256 * 256 * 2}; EpiSloc E{F.SLOC}; pg::gemm_phase(F.lds, G, S, E); }
            p3_scan(F);
            { pg::SrcS5 G{4, 2, 384}; SchedS5 S{F.G, F.bid, (const char*)F.UB, (const char*)F.SIN, (const char*)F.YT, (size_t)256 * 384 * 2}; EpiY E{F.Y2}; pg::gemm_phase(F.lds, G, S, E); }
            attn_phase(F, 0);
            if (fuse_glu) { xcd_barrier(bar); attn_phase(F, 1); }
        } else {
            attn_phase(F, 0);
            if (fuse_glu) {
                xcd_barrier(bar);
                const int ga = F.bid - 128, gu = ((ga & 7) << 4) | (ga >> 3), gpm = gu >> 1;
                pg::SrcPlain G{S5W}; SchedOne S{gpm, gu & 1, (const char*)F.Y2 + (size_t)gpm * 256 * S5W * 2, (const char*)F.WGLU + (size_t)(gu & 1) * 256 * S5W * 2}; EpiGlu E{F.Y2, F.YS5};
                pg::gemm_phase(F.lds, G, S, E);
            }
        }
        if (BOTH(2)) xcd_barrier(bar);
    }
    if (IN(5) && F.G != 256) {
        pg::SrcPlain G{S5W}; SchedTiles S{F.G, F.bid, T / 256, S5W / 256, 1, (const char*)F.Y2, nullptr, (const char*)F.WGLU, nullptr, (size_t)256 * S5W * 2, (size_t)256 * S5W * 2}; EpiGlu E{F.Y2, F.YS5};
        pg::gemm_phase(F.lds, G, S, E);
        if (BOTH(5)) xcd_barrier(bar);
    }
    if (IN(6)) {
        pg::SrcPlain G{SBW}; SchedTiles S{F.G, F.bid, T / 256, D / 256, 2, (const char*)F.YSB, (const char*)F.YS5, (const char*)F.WBSB, (const char*)F.WBS5, (size_t)256 * SBW * 2, (size_t)256 * SBW * 2}; EpiMerge E{F.GSB, F.GS5, F.MRG};
        pg::gemm_phase(F.lds, G, S, E);
        if (BOTH(6)) { if (local_ok) group_barrier(F.ctl, F.bid, 32u); else xcd_barrier(bar); }
    }
    if (IN(7)) {
        pg::SrcPlain G{D}; SchedTiles S{F.G, F.bid, T / 256, D / 256, 1, (const char*)F.MRG, nullptr, (const char*)F.WOUT, nullptr, (size_t)256 * D * 2, (size_t)256 * D * 2}; EpiOut E{F.XB, F.X1BF, F.X1B, F.SS2P, F.norm_ffn};
        pg::gemm_phase(F.lds, G, S, E);
        if (BOTH(7)) { if (local_ok) group_barrier(F.ctl, F.bid, 64u); else xcd_barrier(bar); }
    }
    if (IN(8)) { p8_router(F, F.ctl + CW_CNT, F.LIST, F.GATEL, (float*)(F.ws + WS_RS2L)); if (BOTH(8)) xcd_barrier(bar); }
#if MOE_FP8
#define MOE_UP(S_)   do { pg::SrcGather8 G{D, 6}; EpiUpM E{F.b_up, F.ACT}; pg::gemm_phase_f8m(F.lds, F.lds + META_OFF, G, S_, E); } while (0)
#define MOE_DOWN(S_) do { pg::SrcPlain8 G{DFF, 6}; EpiDownM E{F.b_down, F.YSLOT}; pg::gemm_phase_f8m(F.lds, F.lds + META_OFF, G, S_, E); } while (0)
#define SCHED_UP(off, hi, one)   SchedMoe{off, hi, one, F.G, F.bid, 8, 0, 0, F.LIST, (const float*)(F.ws + WS_RS2L), (const char*)F.X1B, (const char*)F.WUP, (size_t)2 * DFF * D, 0, (size_t)256 * D, true, F.b_up}
#define SCHED_DOWN(off, hi, one) SchedMoe{off, hi, one, F.G, F.bid, 4, 0, 0, F.LIST, F.GATEL, (const char*)F.ACT, (const char*)F.WDN, (size_t)D * DFF, (size_t)256 * DFF, (size_t)256 * DFF, false, F.b_down}
#else
#define MOE_UP(S_)   do { pg::SrcGather G{D}; EpiUp E{(const float*)(F.ws + WS_RS2L), F.b_up, F.ACT}; pg::gemm_phase(F.lds, G, S_, E); } while (0)
#define MOE_DOWN(S_) do { pg::SrcPlain G{DFF}; EpiDown E{F.GATEL, F.b_down, F.YSLOT}; pg::gemm_phase(F.lds, G, S_, E); } while (0)
#define SCHED_UP(off, hi, one)   SchedMoe{off, hi, one, F.G, F.bid, 8, 0, 0, F.LIST, F.GATEL, (const char*)F.X1B, (const char*)F.WUP, (size_t)2 * DFF * D * 2, 0, (size_t)256 * D * 2, true, F.b_up}
#define SCHED_DOWN(off, hi, one) SchedMoe{off, hi, one, F.G, F.bid, 4, 0, 0, F.LIST, F.GATEL, (const char*)F.ACT, (const char*)F.WDN, (size_t)D * DFF * 2, (size_t)256 * DFF * 2, (size_t)256 * DFF * 2, false, F.b_down}
#endif
    if (IN(9)) {
        moe_prefix(F);
        const LAS unsigned* tab = (const LAS unsigned*)(F.lds + MISC_OFF) + 16;
        const bool split = (F.G == 256);
        SchedMoe S0 = SCHED_UP(0, 0, 0); S0.load_tables(tab, F.lane);
        const int RT = S0.total_rt(), FR = RT / 32, nupx = (RT - FR * 32 + 3) / 4;
        { SchedMoe S = SCHED_UP(0, split ? FR * 32 : RT, 0); S.tpre = S0.tpre; S.tcnt = S0.tcnt; MOE_UP(S); }
        if (split) {
            xcd_barrier(bar);
            const int x = F.bid & 7;
            if (x < nupx) { SchedMoe S = SCHED_UP(8 * FR, RT, 1); S.tpre = S0.tpre; S.tcnt = S0.tcnt; MOE_UP(S); }
            else { SchedMoe S = SCHED_DOWN(-nupx, FR * 32, 1); S.tpre = S0.tpre; S.tcnt = S0.tcnt; MOE_DOWN(S); }
        }
        if (BOTH(9)) xcd_barrier(bar);
    }
    if (IN(10)) {
        if (!IN(9)) moe_prefix(F);
        const LAS unsigned* tab = (const LAS unsigned*)(F.lds + MISC_OFF) + 16;
        SchedMoe S = SCHED_DOWN(0, 0, 0); S.load_tables(tab, F.lane);
        const int RT = S.total_rt(), FR = RT / 32, nupx = (RT - FR * 32 + 3) / 4;
        S.rt_hi = RT; S.sb_off = (F.G == 256 && IN(9)) ? 8 - nupx : 0;
        MOE_DOWN(S);
        if (BOTH(10)) xcd_barrier(bar);
    }
    if (IN(11)) p11_final(F, F.out);
#undef IN
#undef BOTH
}

static void launch_mk(Args& a, int lo, int hi, int li, int grid, hipStream_t stream) {
    a.ph_lo = lo; a.ph_hi = hi; a.li = li;
    hipLaunchKernelGGL(mk, dim3(grid), dim3(NWAVES * 64), LDS_BYTES, stream, a);
}
extern "C" void kernel_launch(void* const* d_in, const int* in_sizes, int n_in, void* d_out, int out_size, void* d_ws, size_t ws_size, hipStream_t stream) {
    static int grid = 0;
    if (grid == 0) {
        if (n_in != 23 || ws_size < WS_END3 || out_size != T * D) { fprintf(stderr, "kernel_launch: unexpected n_in %d / out %d / ws %zu\n", n_in, out_size, ws_size); grid = -1; return; }
        int dev = 0, cus = 0;
        if (hipGetDevice(&dev) != hipSuccess || hipDeviceGetAttribute(&cus, hipDeviceAttributeMultiprocessorCount, dev) != hipSuccess) { grid = -1; return; }
        if (hipFuncSetAttribute((const void*)mk, hipFuncAttributeMaxDynamicSharedMemorySize, LDS_BYTES) != hipSuccess) { fprintf(stderr, "kernel_launch: hipFuncSetAttribute failed\n"); grid = -1; return; }
        int per_cu = 0; (void)hipOccupancyMaxActiveBlocksPerMultiprocessor(&per_cu, (const void*)mk, NWAVES * 64, LDS_BYTES); (void)hipGetLastError();
        if (per_cu < 1) fprintf(stderr, "kernel_launch: occupancy query says %d blocks per CU\n", per_cu);
        grid = cus;
    }
    if (grid < 0) return;
    const float* x = (const float*)d_in[0];
    const float* w_glu = (const float*)d_in[11]; const float* w_bsb = (const float*)d_in[12]; const float* w_bs5 = (const float*)d_in[13]; const float* w_out = (const float*)d_in[14];
    const float* norm_ffn = (const float*)d_in[15]; const float* w_router = (const float*)d_in[16]; const float* b_router = (const float*)d_in[17];
    const float* w_up = (const float*)d_in[18]; const float* b_up = (const float*)d_in[19]; const float* w_down = (const float*)d_in[20]; const float* b_down = (const float*)d_in[21];
    const float* norm_final = (const float*)d_in[22];
    unsigned char* ws = (unsigned char*)d_ws; float* out = (float*)d_out;
    unsigned* ctl = (unsigned*)(ws + WS_CTL); float* RSTD2 = (float*)(ws + WS_RSTD2); int* RB = (int*)(ws + WS_RB);
    int* LIST = (int*)(ws + WS_LIST); float* GATEL = (float*)(ws + WS_GATEL);
    bf16_t *QB = (bf16_t*)(ws + WS_QB), *KB = (bf16_t*)(ws + WS_KB), *VT = (bf16_t*)(ws + WS_VT), *UB = (bf16_t*)(ws + WS_UB), *GSB = (bf16_t*)(ws + WS_GSB), *GS5 = (bf16_t*)(ws + WS_GS5);
    bf16_t *YSB = (bf16_t*)(ws + WS_YSB), *Y2 = (bf16_t*)(ws + WS_Y2), *YS5 = (bf16_t*)(ws + WS_YS5), *MRG = (bf16_t*)(ws + WS_MRG), *X1B = (bf16_t*)(ws + WS_X1B), *ACT = (bf16_t*)(ws + WS_ACT), *YSLOT = (bf16_t*)(ws + WS_YSLOT);
    float* TA = (float*)(ws + WS_TMPA); float* TA2 = TA + (size_t)T * D;
    float* TM = (float*)(ws + WS_TMPM); float* TM2 = TM + (size_t)T * 2 * DFF;
    (void)hipMemsetAsync(ws + WS_CTL, 0, CTL_BYTES, stream);
    Args a{}; for (int i = 0; i < 23; ++i) a.in[i] = (const float*)d_in[i]; a.out = out; a.ws = ws;
    launch_mk(a, 0, N_PHASES, 0, grid, stream);
}
```
